# Optimizing an MI355X kernel written in HIP

```python
import math
import jax, jax.numpy as jnp
from jax import lax
import numpy as np

D_MODEL = 2048
BATCH = 8
SEQ = 4096
DEPTH = 4

SB_HEADS = 8
SB_HEAD_DIM = 128
SB_WIDTH = SB_HEADS * SB_HEAD_DIM
QUERY_BLOCK = 128
SSM_WIDTH = D_MODEL // 4
SSM_GROUP = 16
SSM_GROUPS = SSM_WIDTH // SSM_GROUP
SSM_STATE = 64
SCAN_CHUNK = 128
DT_MIN = 1e-3
DT_MAX = 1e-1
MEM_TOKENS = 256
MEM_HEADS = 4
MEM_HEAD_DIM = 128
MEM_WIDTH = MEM_HEADS * MEM_HEAD_DIM
N_BRANCHES = 3
IN_WIDTH = 3 * SB_WIDTH + SSM_WIDTH + MEM_WIDTH + N_BRANCHES * D_MODEL
D_FF = ((8 * D_MODEL + 3 * 256 - 1) // (3 * 256)) * 256
DN_ALPHA = (2 * DEPTH) ** 0.25
DN_BETA = (8 * DEPTH) ** -0.25
LN_EPS = 1e-5

kernel_name = "hybrid_sb_s5_mem_deepnorm"


def _layer_norm(x, g, b):
    xf = x.astype(jnp.float32)
    mu = jnp.mean(xf, axis=-1, keepdims=True)
    var = jnp.mean(jnp.square(xf - mu), axis=-1, keepdims=True)
    return ((xf - mu) * lax.rsqrt(var + LN_EPS) * g + b).astype(x.dtype)


def _stick_breaking_attention(q, k, v):
    bsz, seq, heads, dh = q.shape
    scale = dh ** -0.5
    outs = []
    for i in range(seq // QUERY_BLOCK):
        q0 = i * QUERY_BLOCK
        k_end = q0 + QUERY_BLOCK
        z = jnp.einsum('bqhd,bkhd->bhqk', q[:, q0:k_end], k[:, :k_end]).astype(jnp.float32) * scale
        t_idx = q0 + jnp.arange(QUERY_BLOCK)
        s_idx = jnp.arange(k_end)
        causal = s_idx[None, :] < t_idx[:, None]
        log1m = jnp.where(causal, jax.nn.log_sigmoid(-z), 0.0)
        after = lax.cumsum(log1m, axis=3, reverse=True) - log1m
        logw = jnp.where(causal, jax.nn.log_sigmoid(z) + after, -jnp.inf)
        w = jnp.exp(logw).astype(v.dtype)
        outs.append(jnp.einsum('bhqk,bkhd->bqhd', w, v[:, :k_end]))
    return jnp.concatenate(outs, axis=1)


def _ssm_combine(left, right):
    a1, b1 = left
    a2, b2 = right
    return a1 * a2, a2 * b1 + b2


def _s5(u, lam_re, lam_im, log_dt, b_re, b_im, c_re, c_im, d_skip):
    f32 = jnp.float32
    bsz, seq, _ = u.shape
    uf = u.astype(f32)
    lam = lax.complex(lam_re.astype(f32), lam_im.astype(f32))
    dt = jnp.exp(log_dt.astype(f32))[:, None]
    lam_bar = jnp.exp(lam * dt)
    b_bar = ((lam_bar - 1.0) / lam)[..., None] * lax.complex(b_re.astype(f32), b_im.astype(f32))
    c = lax.complex(c_re.astype(f32), c_im.astype(f32))
    n_chunks = seq // SCAN_CHUNK
    u_chunks = uf.reshape(bsz, n_chunks, SCAN_CHUNK, SSM_GROUPS, SSM_GROUP).transpose(1, 0, 2, 3, 4)

    def chunk_step(h_prev, uc):
        bu = jnp.einsum('gpc,btgc->btgp', b_bar, uc.astype(jnp.complex64))
        a = jnp.broadcast_to(lam_bar, bu.shape)
        a_cum, h_loc = lax.associative_scan(_ssm_combine, (a, bu), axis=1)
        h_all = h_loc + a_cum * h_prev[:, None]
        y = jnp.real(jnp.einsum('gcp,btgp->btgc', c, h_all))
        return h_all[:, -1], y

    h0 = jnp.zeros((bsz, SSM_GROUPS, SSM_STATE), jnp.complex64)
    _, ys = lax.scan(chunk_step, h0, u_chunks)
    y = ys.transpose(1, 0, 2, 3, 4).reshape(bsz, seq, SSM_WIDTH)
    return y + d_skip.astype(f32) * uf


def _memory_attention(q, mem, w_kv):
    bsz, seq, _ = q.shape
    kv = jnp.einsum('bmd,de->bme', mem, w_kv)
    k, v = jnp.split(kv, 2, axis=-1)
    qh = q.reshape(bsz, seq, MEM_HEADS, MEM_HEAD_DIM)
    kh = k.reshape(bsz, MEM_TOKENS, MEM_HEADS, MEM_HEAD_DIM)
    vh = v.reshape(bsz, MEM_TOKENS, MEM_HEADS, MEM_HEAD_DIM)
    s = jnp.einsum('blhd,bmhd->bhlm', qh, kh).astype(jnp.float32) * (MEM_HEAD_DIM ** -0.5)
    p = jax.nn.softmax(s, axis=-1).astype(v.dtype)
    return jnp.einsum('bhlm,bmhd->blhd', p, vh).reshape(bsz, seq, MEM_WIDTH)


def setup_inputs(seed: int = 0) -> dict:
    key = jax.random.key(seed)
    ks = jax.random.split(key, 24)
    f32 = jnp.float32

    def nrm(k, shape, scale):
        return jax.random.normal(k, shape, f32) * scale

    n_idx = jnp.arange(SSM_STATE, dtype=f32)
    lam_im_base = jnp.broadcast_to(math.pi * n_idx, (DEPTH, SSM_GROUPS, SSM_STATE))
    return {
        "x": nrm(ks[0], (BATCH, SEQ, D_MODEL), 1.0),
        "mem": nrm(ks[1], (BATCH, MEM_TOKENS, D_MODEL), 1.0),
        "w_in": nrm(ks[2], (DEPTH, D_MODEL, IN_WIDTH), D_MODEL ** -0.5),
        "b_in": nrm(ks[3], (DEPTH, IN_WIDTH), 0.02),
        "sb_w_out": nrm(ks[4], (DEPTH, SB_WIDTH, D_MODEL), SB_WIDTH ** -0.5),
        "ssm_lambda_re": -0.5 + nrm(ks[5], (DEPTH, SSM_GROUPS, SSM_STATE), 0.01),
        "ssm_lambda_im": lam_im_base + nrm(ks[6], (DEPTH, SSM_GROUPS, SSM_STATE), 0.01),
        "ssm_log_dt": jax.random.uniform(ks[7], (DEPTH, SSM_GROUPS), f32, math.log(DT_MIN), math.log(DT_MAX)),
        "ssm_b_re": nrm(ks[8], (DEPTH, SSM_GROUPS, SSM_STATE, SSM_GROUP), (2 * SSM_GROUP) ** -0.5),
        "ssm_b_im": nrm(ks[9], (DEPTH, SSM_GROUPS, SSM_STATE, SSM_GROUP), (2 * SSM_GROUP) ** -0.5),
        "ssm_c_re": nrm(ks[10], (DEPTH, SSM_GROUPS, SSM_GROUP, SSM_STATE), (2 * SSM_STATE) ** -0.5),
        "ssm_c_im": nrm(ks[11], (DEPTH, SSM_GROUPS, SSM_GROUP, SSM_STATE), (2 * SSM_STATE) ** -0.5),
        "ssm_d": nrm(ks[12], (DEPTH, SSM_WIDTH), 1.0),
        "ssm_w_glu": nrm(ks[13], (DEPTH, SSM_WIDTH, 2 * SSM_WIDTH), SSM_WIDTH ** -0.5),
        "ssm_w_out": nrm(ks[14], (DEPTH, SSM_WIDTH, D_MODEL), SSM_WIDTH ** -0.5),
        "mem_w_kv": nrm(ks[15], (DEPTH, D_MODEL, 2 * MEM_WIDTH), D_MODEL ** -0.5),
        "mem_w_out": nrm(ks[16], (DEPTH, MEM_WIDTH, D_MODEL), MEM_WIDTH ** -0.5),
        "w_o": nrm(ks[17], (DEPTH, D_MODEL, D_MODEL), DN_BETA * D_MODEL ** -0.5),
        "ln1_g": 1.0 + nrm(ks[18], (DEPTH, D_MODEL), 0.02),
        "ln1_b": nrm(ks[19], (DEPTH, D_MODEL), 0.02),
        "ffn_w_gate_up": nrm(ks[20], (DEPTH, D_MODEL, 2 * D_FF), D_MODEL ** -0.5),
        "ffn_w_down": nrm(ks[21], (DEPTH, D_FF, D_MODEL), DN_BETA * D_FF ** -0.5),
        "ln2_g": 1.0 + nrm(ks[22], (DEPTH, D_MODEL), 0.02),
        "ln2_b": nrm(ks[23], (DEPTH, D_MODEL), 0.02),
    }


def reference(x, mem, w_in, b_in, sb_w_out, ssm_lambda_re, ssm_lambda_im, ssm_log_dt,
              ssm_b_re, ssm_b_im, ssm_c_re, ssm_c_im, ssm_d, ssm_w_glu, ssm_w_out,
              mem_w_kv, mem_w_out, w_o, ln1_g, ln1_b, ffn_w_gate_up, ffn_w_down,
              ln2_g, ln2_b):
    bsz, seq, _ = x.shape
    splits = [SB_WIDTH, 2 * SB_WIDTH, 3 * SB_WIDTH,
              3 * SB_WIDTH + SSM_WIDTH, 3 * SB_WIDTH + SSM_WIDTH + MEM_WIDTH]
    for l in range(DEPTH):
        proj = jnp.einsum('bld,de->ble', x, w_in[l]) + b_in[l]
        q_sb, k_sb, v_sb, u_ssm, q_mem, gate_logits = jnp.split(proj, splits, axis=-1)

        hs = (bsz, seq, SB_HEADS, SB_HEAD_DIM)
        sb = _stick_breaking_attention(q_sb.reshape(hs), k_sb.reshape(hs), v_sb.reshape(hs))
        p_sb = jnp.einsum('ble,ed->bld', sb.reshape(bsz, seq, SB_WIDTH), sb_w_out[l])

        y = _s5(u_ssm, ssm_lambda_re[l], ssm_lambda_im[l], ssm_log_dt[l], ssm_b_re[l], ssm_b_im[l],
                ssm_c_re[l], ssm_c_im[l], ssm_d[l])
        g = jax.nn.gelu(y).astype(x.dtype)
        glu_a, glu_b = jnp.split(jnp.einsum('ble,ef->blf', g, ssm_w_glu[l]), 2, axis=-1)
        p_ssm = jnp.einsum('ble,ed->bld', glu_a * jax.nn.sigmoid(glu_b), ssm_w_out[l])

        mm = _memory_attention(q_mem, mem, mem_w_kv[l])
        p_mem = jnp.einsum('ble,ed->bld', mm, mem_w_out[l])

        gates = jax.nn.sigmoid(gate_logits.astype(jnp.float32)).astype(x.dtype)
        gates = gates.reshape(bsz, seq, N_BRANCHES, D_MODEL)
        merged = gates[:, :, 0] * p_sb + gates[:, :, 1] * p_ssm + gates[:, :, 2] * p_mem
        mix_out = jnp.einsum('bld,de->ble', merged, w_o[l])
        x = _layer_norm(DN_ALPHA * x + mix_out, ln1_g[l], ln1_b[l])

        gate_up = jnp.einsum('bld,df->blf', x, ffn_w_gate_up[l])
        f_gate, f_up = jnp.split(gate_up, 2, axis=-1)
        ffn_out = jnp.einsum('blf,fd->bld', jax.nn.silu(f_gate) * f_up, ffn_w_down[l])
        x = _layer_norm(DN_ALPHA * x + ffn_out, ln2_g[l], ln2_b[l])
    return x
```

```cpp
#include <hip/hip_runtime.h>
#include <cstdio>
#include <cstdint>

#define LAS __attribute__((address_space(3)))
#define GAS __attribute__((address_space(1)))
typedef unsigned short bf16;
typedef short bf16x8 __attribute__((ext_vector_type(8)));
typedef short s16x4 __attribute__((ext_vector_type(4)));
typedef float f32x2 __attribute__((ext_vector_type(2)));
typedef float f32x4 __attribute__((ext_vector_type(4)));
typedef float f32x16 __attribute__((ext_vector_type(16)));
typedef unsigned u32x2 __attribute__((ext_vector_type(2)));
typedef unsigned u32x4 __attribute__((ext_vector_type(4)));
typedef _Float16 h16x8 __attribute__((ext_vector_type(8)));
typedef float f32x8 __attribute__((ext_vector_type(8)));

constexpr int BATCH = 8, SEQ = 4096, DM = 2048, DEPTH = 4, M = BATCH * SEQ;
constexpr int SBW = 1024, SSMW = 512, MEMW = 512, INW = 10240, DFF = 5632, MEMT = 256;
constexpr int NG = 32, NP = 64, TCH = 32, NCH = SEQ / TCH, ROWS_G = BATCH * NCH  , K2 = TCH * 16 + 128  ;
constexpr float DN_ALPHA = 1.681792830507429f;
constexpr float LN_EPS = 1e-5f;
constexpr float LOG2E = 1.4426950408889634f;
constexpr float ATT_C = 0.08838834764831845f * 1.4426950408889634f;

constexpr size_t MiB = 1u << 20;
constexpr size_t WS_CTL = 0, CTL_ZERO_BYTES = 1 * MiB;
constexpr size_t WS_BT_IN = 1 * MiB;
constexpr size_t WS_BT_CAT = WS_BT_IN + 40 * MiB;
constexpr size_t WS_BT_GLU = WS_BT_CAT + 8 * MiB;
constexpr size_t WS_BT_KV = WS_BT_GLU + 1 * MiB;
constexpr size_t WS_BT_O = WS_BT_KV + 4 * MiB;
constexpr size_t WS_BT_GU = WS_BT_O + 8 * MiB;
constexpr size_t WS_BT_DN = WS_BT_GU + 44 * MiB;
constexpr size_t WS_BT_S1 = WS_BT_DN + 22 * MiB;
constexpr size_t WS_BT_S2 = WS_BT_S1 + 8 * MiB;
constexpr size_t WS_KC = WS_BT_S2 + 20 * MiB;
constexpr size_t WS_LP = WS_KC + 4 * MiB;
constexpr size_t WS_CF = WS_LP + 2304 * 1024;
constexpr size_t WS_STAT = WS_CF + 128 * 1024;
constexpr size_t WS_XB = WS_LP + 3 * MiB;
constexpr size_t WS_QKV = WS_XB + 128 * MiB;
constexpr size_t WS_GATES = WS_QKV + 192 * MiB;
constexpr size_t WS_HID = WS_QKV;
constexpr size_t WS_QM = WS_GATES + 384 * MiB;
constexpr size_t WS_A2 = WS_QM + 32 * MiB;
constexpr size_t WS_S = WS_A2 + 40 * MiB;
constexpr size_t WS_KVM = WS_S + 16 * MiB;
constexpr size_t WS_MEMB = WS_KVM + 4 * MiB;
constexpr size_t WS_ACAT = WS_MEMB + 8 * MiB;
constexpr size_t WS_GBUF = WS_ACAT + 128 * MiB;
constexpr size_t WS_MERGED = WS_XB;
constexpr size_t WS_BT_KV4 = WS_GBUF + 32 * MiB;
constexpr size_t WS_KVM4 = WS_BT_KV4 + 16 * MiB;
constexpr size_t WS_PRE = WS_KVM4 + 16 * MiB;
constexpr size_t WS_END = WS_PRE + 128 * MiB;
static_assert(WS_HID + (size_t)M * DFF * 2 <= WS_QM, "hid overlay");
constexpr size_t WS_ALT_DELTA = (WS_GATES + 192 * MiB) - WS_BT_IN;
static_assert(WS_GATES + 192 * MiB >= WS_HID + (size_t)M * DFF * 2 && WS_GATES + 192 * MiB + (WS_KC - WS_BT_IN) <= WS_QM, "second weight copy");
static_assert((size_t)4 * 32 * 33 * 64 * 8 <= 2304 * 1024 && (size_t)4 * 32 * 64 * 8 <= 128 * 1024 && WS_STAT + (size_t)M * 8 <= WS_XB, "LP/CF/STAT");

constexpr int CW_BAR = 4096;
constexpr int CW_GBAR = 8192;

constexpr int RING_BYTES = 131072;
constexpr int MISC_OFF = RING_BYTES;
constexpr int ATTWS_OFF = RING_BYTES + 512;
constexpr int ATTFLG_OFF = ATTWS_OFF + 2048;
constexpr int LDS_BYTES = 147456;

typedef __bf16 bf16x2_t __attribute__((ext_vector_type(2)));
__device__ __forceinline__ unsigned cvt_pk_bf16(float lo, float hi) { f32x2 v = {lo, hi}; bf16x2_t b = __builtin_convertvector(v, bf16x2_t); return __builtin_bit_cast(unsigned, b); }
__device__ __forceinline__ unsigned rne_w7(float v) { const unsigned u = __float_as_uint(v); return (u + 0xFFFFu + ((u >> 17) & 1u)) & 0xFFFE0000u; }
__device__ __forceinline__ unsigned cvt_pk_w7(float lo, float hi) { return (rne_w7(lo) >> 16) | rne_w7(hi); }
__device__ __forceinline__ float bf_lo(unsigned w) { return __uint_as_float(w << 16); }
__device__ __forceinline__ float bf_hi(unsigned w) { return __uint_as_float(w & 0xffff0000u); }
__device__ __forceinline__ float fast_sigmoid(float v) { return __builtin_amdgcn_rcpf(1.0f + __builtin_amdgcn_exp2f(-v * LOG2E)); }
__device__ __forceinline__ unsigned pack_gate4(f32x4 g) { unsigned w = 0u; w = __builtin_amdgcn_cvt_pk_u8_f32(g[0] * 256.0f - 0.5f, 0, w); w = __builtin_amdgcn_cvt_pk_u8_f32(g[1] * 256.0f - 0.5f, 1, w);
    w = __builtin_amdgcn_cvt_pk_u8_f32(g[2] * 256.0f - 0.5f, 2, w); w = __builtin_amdgcn_cvt_pk_u8_f32(g[3] * 256.0f - 0.5f, 3, w); return w; }
__device__ __forceinline__ f32x4 unpack_gate4(unsigned w) { const f32x4 q = {(float)(w & 0xffu), (float)((w >> 8) & 0xffu), (float)((w >> 16) & 0xffu), (float)(w >> 24)};
    return q * (1.0f / 256.0f) + (0.5f / 256.0f); }
__device__ __forceinline__ u32x4 pack8(f32x4 a, f32x4 b) { u32x4 w; w.x = cvt_pk_bf16(a[0], a[1]); w.y = cvt_pk_bf16(a[2], a[3]); w.z = cvt_pk_bf16(b[0], b[1]); w.w = cvt_pk_bf16(b[2], b[3]); return w; }
__device__ __forceinline__ u32x4 pack8_w7(f32x4 a, f32x4 b) { u32x4 w; w.x = cvt_pk_w7(a[0], a[1]); w.y = cvt_pk_w7(a[2], a[3]); w.z = cvt_pk_w7(b[0], b[1]); w.w = cvt_pk_w7(b[2], b[3]); return w; }
__device__ __forceinline__ void unpack8(u32x4 w, f32x4& a, f32x4& b) { a = (f32x4){bf_lo(w.x), bf_hi(w.x), bf_lo(w.y), bf_hi(w.y)}; b = (f32x4){bf_lo(w.z), bf_hi(w.z), bf_lo(w.w), bf_hi(w.w)}; }

namespace pg8 {
constexpr int BM = 256, BK = 64, HALF = 128, HTB = HALF * BK * 2, STAGE_BYTES = 8 * HTB, NXCD = 8, WGM = 4;
__host__ __device__ __forceinline__ int lds_byte(int r, int c) { const int st = (r >> 4) * 2 + (c >> 5), rr = r & 15, cc = c & 31, ob = rr * 64 + cc * 2; return st * 1024 + (ob ^ (((ob >> 9) & 1) << 5)); }
__host__ __device__ __forceinline__ void stage_rc(int b, int& R, int& C) { const int st = b / 1024, sb = b % 1024, swz = sb ^ (((sb >> 9) & 1) << 5); R = (st >> 1) * 16 + swz / 64; C = (st & 1) * 32 + (swz % 64) / 2; }
__host__ __device__ __forceinline__ int perm32(int rho) { const int n = rho >> 4, i = rho & 15; return 8 * (i >> 2) + 4 * n + (i & 3); }

constexpr int BJ = 32;
struct Unit { int pm, pn, k0, nt, tag; };
struct Gemm { const bf16* A; const bf16* Bt; int lda, ldb; };

__device__ __forceinline__ void tile_of(int wgid, int nM, int nN, int& pm, int& pn) {
    const int nwg = nM * nN;
    { const int q = nwg / NXCD, r = nwg % NXCD, xcd = wgid % NXCD, off = wgid / NXCD; wgid = (xcd < r ? xcd * (q + 1) : r * (q + 1) + (xcd - r) * q) + off; }
    const int nig = WGM * nN, gid = wgid / nig, fm = gid * WGM, gsz = (nM - fm) < WGM ? (nM - fm) : WGM;
    pm = fm + ((wgid % nig) % gsz); pn = (wgid % nig) / gsz;
}
struct StaticOrder {
    int nM, nN, nwg, G, c, nt;
    __device__ __forceinline__ void init(int Mr, int Nc, int K, int G_, int c_) { nM = Mr / BM; nN = Nc / BM; nwg = nM * nN; G = G_; c = c_; nt = K / BK; }
    __device__ __forceinline__ bool next(int i, Unit& u) const {
        const long L = (long)i * G + c; if (L >= nwg) return false;
        tile_of((int)L, nM, nN, u.pm, u.pn); u.k0 = 0; u.nt = nt; u.tag = 0; return true; }
};
struct MergeOrder {
    int nM, nN, nwg, G, c;
    __device__ __forceinline__ void init(int Mr, int Nc, int G_, int c_) { nM = Mr / BM; nN = Nc / BM; nwg = nM * nN; G = G_; c = c_; }
    __device__ __forceinline__ bool next(int i, Unit& u) const {
        const int ti = i / 3, j = i - 3 * ti; const long L = (long)ti * G + c; if (L >= nwg) return false;
        tile_of((int)L, nM, nN, u.pm, u.pn); u.tag = j; u.k0 = (j == 0) ? 0 : (j == 1 ? 1024 : 1536); u.nt = (j == 0) ? 16 : 8; return true; }
};
struct S5Order1 {
    int G, c;
    __device__ __forceinline__ bool next(int i, Unit& u) const {
        const int L = i * G + c; if (L >= 128) return false;
        u.pm = L; u.pn = L >> 2; u.k0 = 0; u.nt = 8; u.tag = 0; return true; }
};
struct S5Order2L {
    int G, c;
    __device__ __forceinline__ bool next(int i, Unit& u) const {
        const int L = (i >> 1) * G + c; if (L >= 128) return false;
        u.pm = L; u.pn = (L >> 2) * 2 + (i & 1); u.k0 = 0; u.nt = 10; u.tag = 0; return true; }
};
struct S5Order2 {
    int G, c;
    __device__ __forceinline__ bool next(int i, Unit& u) const {
        const int L = i * G + c; if (L >= 256) return false;
        const int g = L >> 3, r = L & 7; u.pm = g * 4 + (r >> 1); u.pn = g * 2 + (r & 1); u.k0 = 0; u.nt = 10; u.tag = 0; return true; }
};

template <class Epi, class Sched>
__device__ __forceinline__ void gemm_phase(LAS unsigned char* lds, const Gemm g, const Sched& S, const Epi& E) {
    int tid = threadIdx.x; asm volatile("" : "+v"(tid));
    const int wid = __builtin_amdgcn_readfirstlane(tid >> 6), lane = tid & 63, wr = wid >> 2, wc = wid & 3, fr = lane & 15, fq = lane >> 4;
    unsigned voffA[2], voffB[2];
#pragma unroll
    for (int i = 0; i < 2; ++i) { int R, C; stage_rc(tid * 16 + i * 8192, R, C); const int Rb = Epi::PERM ? (64 * (R >> 5) + perm32(R & 31)) : R;
        voffA[i] = (unsigned)(R * g.lda + C) * 2u; voffB[i] = (unsigned)(Rb * g.ldb + C) * 2u; }
    const size_t kstep = (size_t)(BK * 2);
    const size_t hA = (size_t)HALF * g.lda * 2, hB = (size_t)(Epi::PERM ? BJ : HALF) * g.ldb * 2;
    const size_t tA = 2 * hA, tB = (size_t)BM * g.ldb * 2;
    const unsigned ldsw = (unsigned)wid * 1024u;
    const int aoff = lds_byte(wr * 64 + fr, fq * 8), boff = lds_byte(wc * 32 + fr, fq * 8);
#define PG8_SA(b, h) (((b) * 2 + (h)) * HTB)
#define PG8_SB(b, h) ((4 + (b) * 2 + (h)) * HTB)
#define PG8_STAGE(bufoff, gbase, voff) do { _Pragma("unroll") for (int _i = 0; _i < 2; ++_i) \
        __builtin_amdgcn_global_load_lds((const unsigned*)((const char*)(gbase) + (voff)[_i]), (LAS unsigned*)(lds + (bufoff) + ldsw + _i * 8192), 16, 0, 0); } while (0)
#define PG8_LDA(dst, b, h) do { _Pragma("unroll") for (int m = 0; m < 4; ++m) _Pragma("unroll") for (int k = 0; k < 2; ++k) dst[m][k] = *(const LAS bf16x8*)(lds + PG8_SA(b, h) + aoff + m * 2048 + k * 1024); } while (0)
#define PG8_LDB(dst, b, h) do { _Pragma("unroll") for (int n = 0; n < 2; ++n) _Pragma("unroll") for (int k = 0; k < 2; ++k) dst[n][k] = *(const LAS bf16x8*)(lds + PG8_SB(b, h) + boff + n * 2048 + k * 1024); } while (0)
#define PG8_MMA(ai, bj, At, Bt) do { __builtin_amdgcn_s_setprio(1); _Pragma("unroll") for (int m = 0; m < 4; ++m) _Pragma("unroll") for (int n = 0; n < 2; ++n) _Pragma("unroll") for (int k = 0; k < 2; ++k) \
        acc[ai][bj][m][n] = __builtin_amdgcn_mfma_f32_16x16x32_bf16(Bt[n][k], At[m][k], acc[ai][bj][m][n], 0, 0, 0); __builtin_amdgcn_s_setprio(0); } while (0)
#define PG8_WAIT_V(n) asm volatile("s_waitcnt vmcnt(" #n ")" ::: "memory")
#define PG8_WAIT_L(n) asm volatile("s_waitcnt lgkmcnt(" #n ")" ::: "memory")
#define PG8_BAR __builtin_amdgcn_s_barrier()
#define PG8_SCHED __builtin_amdgcn_sched_barrier(0)
    Unit cur, nxt; int ui = 0;
    if (!S.next(0, cur)) return;
    f32x4 acc[2][2][4][2];
#pragma unroll
    for (int a = 0; a < 2; ++a)
#pragma unroll
        for (int b = 0; b < 2; ++b)
#pragma unroll
            for (int m = 0; m < 4; ++m)
#pragma unroll
                for (int n = 0; n < 2; ++n) acc[a][b][m][n] = (f32x4){0.f, 0.f, 0.f, 0.f};
    bf16x8 At[4][2], B0[2][2], B1[2][2];
    const char* cA = (const char*)g.A + (size_t)cur.pm * tA + (size_t)cur.k0 * 2; const char* cB = (const char*)g.Bt + (size_t)cur.pn * tB + (size_t)cur.k0 * 2;
    PG8_STAGE(PG8_SB(0, 0), cB, voffB); PG8_STAGE(PG8_SB(0, 1), cB + hB, voffB); PG8_STAGE(PG8_SA(0, 0), cA, voffA); PG8_STAGE(PG8_SA(0, 1), cA + hA, voffA);
    if (wr == 1) PG8_BAR;
    PG8_WAIT_V(2); PG8_BAR;
    PG8_STAGE(PG8_SB(1, 0), cB + kstep, voffB); PG8_STAGE(PG8_SA(1, 0), cA + kstep, voffA); PG8_STAGE(PG8_SB(1, 1), cB + hB + kstep, voffB);
    PG8_WAIT_V(6); PG8_BAR;
    for (;;) {
        const bool has_next = S.next(ui + 1, nxt);
        const char* nA = has_next ? (const char*)g.A + (size_t)nxt.pm * tA + (size_t)nxt.k0 * 2 : cA; const char* nB = has_next ? (const char*)g.Bt + (size_t)nxt.pn * tB + (size_t)nxt.k0 * 2 : cB;
        const int nt = cur.nt;
        for (int t = 0; t < nt; t += 2) {
            const bool last = (t == nt - 2);
            const char* a1 = cA + (size_t)(t + 1) * kstep;
            const char* a2 = last ? nA : cA + (size_t)(t + 2) * kstep; const char* b2 = last ? nB : cB + (size_t)(t + 2) * kstep;
            const char* a3 = a2 + kstep; const char* b3 = b2 + kstep;
            PG8_LDB(B0, 0, 0); PG8_LDB(B1, 0, 1); PG8_SCHED; PG8_LDA(At, 0, 0); PG8_STAGE(PG8_SA(1, 1), a1 + hA, voffA);
            PG8_WAIT_V(8); PG8_WAIT_L(0); PG8_BAR; PG8_MMA(0, 0, At, B0); PG8_MMA(0, 1, At, B1); PG8_BAR; PG8_SCHED;
            PG8_LDA(At, 0, 1); PG8_STAGE(PG8_SB(0, 0), b2, voffB); PG8_STAGE(PG8_SB(0, 1), b2 + hB, voffB); PG8_STAGE(PG8_SA(0, 0), a2, voffA);
            PG8_WAIT_V(8); PG8_WAIT_L(0); PG8_BAR; PG8_MMA(1, 0, At, B0); PG8_MMA(1, 1, At, B1); PG8_BAR; PG8_SCHED;
            PG8_LDB(B0, 1, 0); PG8_LDB(B1, 1, 1); PG8_SCHED; PG8_LDA(At, 1, 0); PG8_STAGE(PG8_SA(0, 1), a2 + hA, voffA);
            PG8_WAIT_V(8); PG8_WAIT_L(0); PG8_BAR; PG8_MMA(0, 0, At, B0); PG8_MMA(0, 1, At, B1); PG8_BAR; PG8_SCHED;
            PG8_LDA(At, 1, 1); PG8_STAGE(PG8_SB(1, 0), b3, voffB); PG8_STAGE(PG8_SB(1, 1), b3 + hB, voffB); PG8_STAGE(PG8_SA(1, 0), a3, voffA);
            PG8_WAIT_V(8); PG8_WAIT_L(0); PG8_BAR; PG8_MMA(1, 0, At, B0); PG8_MMA(1, 1, At, B1); PG8_BAR; PG8_SCHED;
        }
        if (wr == 0) PG8_BAR;
        E(acc, cur, wr, wc, fr, fq);
        if (!has_next) break;
        if (!E.keep(cur)) {
            bf16x8 zf = {0, 0, 0, 0, 0, 0, 0, 0}; asm volatile("" : "+v"(zf));
#pragma unroll
            for (int a = 0; a < 2; ++a)
#pragma unroll
                for (int b = 0; b < 2; ++b)
#pragma unroll
                    for (int m = 0; m < 4; ++m)
#pragma unroll
                        for (int n = 0; n < 2; ++n) acc[a][b][m][n] = __builtin_amdgcn_mfma_f32_16x16x32_bf16(zf, zf, (f32x4){0.f, 0.f, 0.f, 0.f}, 0, 0, 0);
        }
        cur = nxt; cA = nA; cB = nB; ++ui;
        if (wr == 1) PG8_BAR;
    }
    PG8_WAIT_V(0);
    PG8_BAR;
#undef PG8_SA
#undef PG8_SB
#undef PG8_STAGE
#undef PG8_LDA
#undef PG8_LDB
#undef PG8_MMA
#undef PG8_WAIT_V
#undef PG8_WAIT_L
#undef PG8_BAR
#undef PG8_SCHED
}

typedef f32x4 Acc[2][2][4][2];
__device__ __forceinline__ void store_pair128(void* pv, size_t row8_bytes, u32x4 d0, u32x4 d1, bool lo) { char* p = (char*)pv;
    u32x4 s0, s1;
#pragma unroll
    for (int i = 0; i < 4; ++i) { const unsigned snd = lo ? d1[i] : d0[i]; const unsigned rcv = (unsigned)__builtin_amdgcn_mov_dpp((int)snd, 0x128, 0xf, 0xf, true); s0[i] = lo ? d0[i] : rcv; s1[i] = lo ? rcv : d1[i]; }
    *(u32x4*)p = s0; *(u32x4*)(p + row8_bytes) = s1;
}
struct EpiInProj {
    static constexpr bool PERM = true;
    const float* bias; bf16* qkv; bf16* a2; bf16* qm; unsigned char* gates;
    __device__ __forceinline__ bool keep(const Unit&) const { return false; }
    __device__ __forceinline__ void operator()(Acc& acc, const Unit& u, int wr, int wc, int fr, int fq) const {
        const int rowb = u.pm * BM + wr * 64 + fr, colb = u.pn * BM + wc * 64 + 8 * fq;
        bf16* base; int sA, sM2, sM1, r8 = 0; bool sig = false; const bool lo = fr < 8; const int rowx = rowb - fr + (fr & 7), cx = lo ? 0 : BJ;
        if (u.pn < 12) { base = qkv + (size_t)rowx * 3072 + colb + cx; sA = 128 * 3072; sM2 = 32 * 3072; sM1 = 16 * 3072; r8 = 8 * 3072 * 2; }
        else if (u.pn < 14) { const int ch = colb - 3072, gg = ch >> 4, c = ch & 15;
            base = a2 + ((size_t)(gg * ROWS_G + u.pm * 8 + wr * 2) * K2 + fr * 16 + c); sA = 4 * K2; sM2 = K2; sM1 = 256; }
        else if (u.pn < 16) { base = qm + (size_t)rowx * 512 + (colb - 3584) + cx; sA = 128 * 512; sM2 = 32 * 512; sM1 = 16 * 512; r8 = 8 * 512 * 2; }
        else { base = (bf16*)(gates + (size_t)rowb * 6144 + (colb - 4096)); sA = 64 * 6144; sM2 = 16 * 6144; sM1 = 8 * 6144; sig = true; }
        const int sB = (u.pn >= 12 && u.pn < 14) ? 2 * ROWS_G * K2 : (u.pn >= 16 ? BJ / 2 : BJ);
        f32x4 bv[2][2];
#pragma unroll
        for (int bj = 0; bj < 2; ++bj)
#pragma unroll
            for (int n = 0; n < 2; ++n) bv[bj][n] = *(const f32x4*)(bias + colb + bj * BJ + 4 * n);
#pragma unroll
        for (int ai = 0; ai < 2; ++ai)
#pragma unroll
            for (int m = 0; m < 4; ++m) { bf16* rowp = base + (size_t)ai * sA + (size_t)(m >> 1) * sM2 + (size_t)(m & 1) * sM1; u32x4 pk[2];
#pragma unroll
                for (int bj = 0; bj < 2; ++bj) { f32x4 v0 = acc[ai][bj][m][0] + bv[bj][0], v1 = acc[ai][bj][m][1] + bv[bj][1];
                    if (sig) {
#pragma unroll
                        for (int e = 0; e < 4; ++e) { v0[e] = fast_sigmoid(v0[e]); v1[e] = fast_sigmoid(v1[e]); }
                        *(u32x2*)(rowp + (size_t)bj * sB) = (u32x2){pack_gate4(v0), pack_gate4(v1)}; }
                    else pk[bj] = pack8(v0, v1); }
                if (!sig) { if (r8) store_pair128(rowp, (size_t)r8, pk[0], pk[1], lo); else { *(u32x4*)rowp = pk[0]; *(u32x4*)(rowp + (size_t)sB) = pk[1]; } } }
    }
};
struct EpiStoreBf16 {
    static constexpr bool PERM = true;
    bf16* O; int ldc;
    __device__ __forceinline__ bool keep(const Unit&) const { return false; }
    __device__ __forceinline__ void operator()(Acc& acc, const Unit& u, int wr, int wc, int fr, int fq) const {
        const int row0 = u.pm * BM + wr * 64 + fr, colb = u.pn * BM + wc * 64 + 8 * fq;
#pragma unroll
        for (int ai = 0; ai < 2; ++ai)
#pragma unroll
            for (int m = 0; m < 4; ++m)
#pragma unroll
                for (int bj = 0; bj < 2; ++bj) *(u32x4*)(O + (size_t)(row0 + ai * HALF + m * 16) * ldc + colb + bj * BJ) = pack8(acc[ai][bj][m][0], acc[ai][bj][m][1]);
    }
};
template <int MODE> struct EpiGated {
    static constexpr bool PERM = true;
    bf16* O; int ldc;
    __device__ __forceinline__ bool keep(const Unit&) const { return false; }
    __device__ __forceinline__ void operator()(Acc& acc, const Unit& u, int wr, int wc, int fr, int fq) const {
        const int row0 = u.pm * BM + wr * 64 + fr, col = u.pn * HALF + wc * 32 + 8 * fq;
#pragma unroll
        for (int ai = 0; ai < 2; ++ai)
#pragma unroll
            for (int m = 0; m < 4; ++m) { f32x4 o[2];
#pragma unroll
                for (int n = 0; n < 2; ++n)
#pragma unroll
                    for (int e = 0; e < 4; ++e) { const float a = acc[ai][0][m][n][e], b = acc[ai][1][m][n][e]; o[n][e] = (MODE == 0) ? a * fast_sigmoid(a) * b : a * fast_sigmoid(b); }
                *(u32x4*)(O + (size_t)(row0 + ai * HALF + m * 16) * ldc + col) = pack8(o[0], o[1]); }
    }
};
struct EpiMerge {
    static constexpr bool PERM = true;
    const unsigned char* gates; bf16* O;
    __device__ __forceinline__ bool keep(const Unit& u) const { return u.tag < 2; }
    __device__ __forceinline__ void operator()(Acc& acc, const Unit& u, int wr, int wc, int fr, int fq) const {
        const int row0 = u.pm * BM + wr * 64 + fr, colb = u.pn * BM + wc * 64 + 8 * fq, j = u.tag;
#pragma unroll
        for (int ai = 0; ai < 2; ++ai)
#pragma unroll
            for (int m = 0; m < 4; ++m) { const int row = row0 + ai * HALF + m * 16;
#pragma unroll
                for (int bj = 0; bj < 2; ++bj) { const int col = colb + bj * BJ; const unsigned char* gp = gates + (size_t)row * 6144 + j * 2048 + col;
                    const u32x2 gw = *(const u32x2*)gp; const f32x4 g0 = unpack_gate4(gw.x), g1 = unpack_gate4(gw.y);
                    if (j < 2) { const u32x2 hw = *(const u32x2*)(gp + 2048); const f32x4 h0 = unpack_gate4(hw.x), h1 = unpack_gate4(hw.y);
#pragma unroll
                        for (int e = 0; e < 4; ++e) { acc[ai][bj][m][0][e] *= g0[e] * __builtin_amdgcn_rcpf(fmaxf(h0[e], 1e-30f)); acc[ai][bj][m][1][e] *= g1[e] * __builtin_amdgcn_rcpf(fmaxf(h1[e], 1e-30f)); } }
                    else *(u32x4*)(O + (size_t)row * 2048 + col) = pack8(acc[ai][bj][m][0] * g0, acc[ai][bj][m][1] * g1); } }
    }
};
struct EpiRes {
    static constexpr bool PERM = true;
    const float* x; _Float16* pre; const f32x2* st; const float* gam; const float* bet;
    __device__ __forceinline__ bool keep(const Unit&) const { return false; }
    __device__ __forceinline__ void operator()(Acc& acc, const Unit& u, int wr, int wc, int fr, int fq) const {
        const int row0 = u.pm * BM + wr * 64 + fr, colb = u.pn * BM + wc * 64 + 8 * fq;
        const bool lo = fr < 8; const size_t sbase = (size_t)(row0 - fr + (fr & 7)) * DM + colb + (lo ? 0 : BJ);
        f32x4 gv[2][2], bv[2][2];
        if (!x) {
#pragma unroll
            for (int bj = 0; bj < 2; ++bj)
#pragma unroll
                for (int n = 0; n < 2; ++n) { gv[bj][n] = *(const f32x4*)(gam + colb + bj * BJ + 4 * n) * DN_ALPHA; bv[bj][n] = *(const f32x4*)(bet + colb + bj * BJ + 4 * n) * DN_ALPHA; }
        }
        if (x) {
#pragma unroll
            for (int ai = 0; ai < 2; ++ai)
#pragma unroll
                for (int m = 0; m < 4; ++m) { const size_t ro = (size_t)(row0 + ai * HALF + m * 16) * DM + colb; u32x4 dd[2];
#pragma unroll
                    for (int bj = 0; bj < 2; ++bj) { const f32x4 r0 = *(const f32x4*)(x + ro + bj * BJ), r1 = *(const f32x4*)(x + ro + bj * BJ + 4);
                        const f32x4 o0 = r0 * DN_ALPHA + acc[ai][bj][m][0], o1 = r1 * DN_ALPHA + acc[ai][bj][m][1];
                        const f32x8 o = {o0[0], o0[1], o0[2], o0[3], o1[0], o1[1], o1[2], o1[3]};
                        dd[bj] = __builtin_bit_cast(u32x4, __builtin_convertvector(o, h16x8)); }
                    store_pair128(pre + sbase + (size_t)(ai * HALF + m * 16) * DM, (size_t)8 * DM * 2, dd[0], dd[1], lo);
                    if (m & 1) asm volatile("" ::: "memory"); }
        } else {
#pragma unroll
            for (int ai = 0; ai < 2; ++ai)
#pragma unroll
              for (int mp = 0; mp < 4; mp += 2) {
                f32x2 ms[2]; h16x8 rr[2][2];
#pragma unroll
                for (int m = 0; m < 2; ++m) { const int row = row0 + ai * HALF + (mp + m) * 16; ms[m] = st[row];
#pragma unroll
                    for (int bj = 0; bj < 2; ++bj) rr[m][bj] = *(const h16x8*)(pre + (size_t)row * DM + colb + bj * BJ); }
                asm volatile("" ::: "memory");
#pragma unroll
                for (int m = 0; m < 2; ++m) { u32x4 dd[2];
#pragma unroll
                    for (int bj = 0; bj < 2; ++bj) { const f32x8 r = __builtin_convertvector(rr[m][bj], f32x8);
                        const f32x4 r0 = {r[0], r[1], r[2], r[3]}, r1 = {r[4], r[5], r[6], r[7]};
                        const f32x4 o0 = ((r0 - ms[m].x) * ms[m].y) * gv[bj][0] + bv[bj][0] + acc[ai][bj][mp + m][0], o1 = ((r1 - ms[m].x) * ms[m].y) * gv[bj][1] + bv[bj][1] + acc[ai][bj][mp + m][1];
                        const f32x8 o = {o0[0], o0[1], o0[2], o0[3], o1[0], o1[1], o1[2], o1[3]};
                        dd[bj] = __builtin_bit_cast(u32x4, __builtin_convertvector(o, h16x8)); }
                    store_pair128(pre + sbase + (size_t)(ai * HALF + (mp + m) * 16) * DM, (size_t)8 * DM * 2, dd[0], dd[1], lo); }
                asm volatile("" ::: "memory"); }
        }
    }
};
struct EpiS1 {
    static constexpr bool PERM = false;
    float* S;
    __device__ __forceinline__ bool keep(const Unit&) const { return false; }
    __device__ __forceinline__ void operator()(Acc& acc, const Unit& u, int wr, int wc, int fr, int fq) const {
        const int row0 = u.pm * BM + wr * 64 + fr, colb = wc * 32 + 4 * fq;
#pragma unroll
        for (int ai = 0; ai < 2; ++ai)
#pragma unroll
            for (int m = 0; m < 4; ++m)
#pragma unroll
                for (int n = 0; n < 2; ++n) *(f32x4*)(S + (size_t)(row0 + ai * HALF + m * 16) * 128 + colb + n * 16) = acc[ai][0][m][n];
    }
};
struct EpiS2 {
    static constexpr bool PERM = true;
    const bf16* a2; const float* dskip; bf16* gbuf;
    __device__ __forceinline__ bool keep(const Unit&) const { return false; }
    __device__ __forceinline__ void operator()(Acc& acc, const Unit& u, int wr, int wc, int fr, int fq) const {
        const int R0 = u.pm * BM + wr * 64 + fr, gg = u.pm >> 2, nb = (u.pn & 1) * BM + wc * 64 + 8 * fq;
#pragma unroll
        for (int bj = 0; bj < 2; ++bj) { const int np = nb + bj * BJ, i = np >> 4, c0 = np & 15;
            const f32x4 d0 = *(const f32x4*)(dskip + gg * 16 + c0), d1 = *(const f32x4*)(dskip + gg * 16 + c0 + 4);
#pragma unroll
            for (int ai = 0; ai < 2; ++ai)
#pragma unroll
                for (int m = 0; m < 4; ++m) { const int R = R0 + ai * HALF + m * 16; const int token = (R & (ROWS_G - 1)) * TCH + i;
                    f32x4 u0, u1; unpack8(*(const u32x4*)(a2 + (size_t)R * K2 + i * 16 + c0), u0, u1);
                    f32x4 y0 = acc[ai][bj][m][0] + d0 * u0, y1 = acc[ai][bj][m][1] + d1 * u1;
#pragma unroll
                    for (int e = 0; e < 4; ++e) { { const float y = y0[e]; const float t = 1.5957691216057308f * y * (1.0f + 0.044715f * y * y); y0[e] = y * fast_sigmoid(t); }
                                                  { const float y = y1[e]; const float t = 1.5957691216057308f * y * (1.0f + 0.044715f * y * y); y1[e] = y * fast_sigmoid(t); } }
                    *(u32x4*)(gbuf + (size_t)token * 512 + gg * 16 + c0) = pack8(y0, y1); } }
    }
};
}

namespace att {
constexpr int QBLK = 32, KVBLK = 64;
constexpr int SHM_T = 16384;
#define KSWZ(row, colB) ((row) * 256 + ((colB) ^ (((row) & 7) << 4)))
#define SBAR() __builtin_amdgcn_sched_barrier(0)
__device__ __forceinline__ int crow(int r, int hi) { return (r & 3) + 8 * (r >> 2) + 4 * hi; }
__device__ __forceinline__ void qkt(f32x16& p0, f32x16& p1, const LAS char* Ks, const bf16x8* qr, int r32, int hi) {
    p0 = f32x16{}; p1 = f32x16{};
    bf16x8 kf[16];
#pragma unroll
    for (int d0 = 0; d0 < 8; ++d0) { const int cb = (d0 * 16 + hi * 8) * 2;
        kf[2 * d0] = *(const LAS bf16x8*)(Ks + KSWZ(r32, cb)); kf[2 * d0 + 1] = *(const LAS bf16x8*)(Ks + KSWZ(32 + r32, cb)); }
    SBAR();
#pragma unroll
    for (int d0 = 0; d0 < 8; ++d0) {
        p0 = __builtin_amdgcn_mfma_f32_32x32x16_bf16(kf[2 * d0], qr[d0], p0, 0, 0, 0);
        p1 = __builtin_amdgcn_mfma_f32_32x32x16_bf16(kf[2 * d0 + 1], qr[d0], p1, 0, 0, 0); }
}
__device__ __forceinline__ int v_st(int k, int c) { const int kk = (k & ~0xC) | ((k & 4) << 1) | ((k & 8) >> 1); return ((kk >> 3) * 4 + (c >> 5)) * 512 + ((kk & 7) * 32 + (c & 31)) * 2; }
__device__ __forceinline__ int v_rd_base(int lane) { return ((lane & 3) << 3) | (((lane >> 2) & 3) << 6) | (((lane >> 4) & 1) << 5) | (((lane >> 5) & 1) << 8); }
constexpr int v_rd_off(int d0, int ks, int half) { return d0 * 512 + ks * 4096 + half * 2048; }
template <int OFF> __device__ __forceinline__ s16x4 tr_read(int vb) { s16x4 r; asm volatile("ds_read_b64_tr_b16 %0, %1 offset:%2" : "=&v"(r) : "v"(vb), "i"(OFF) : "memory"); return r; }
template <int D0> __device__ __forceinline__ void pv_one(f32x16& od, int vb, bf16x8 pa0, bf16x8 pa1, bf16x8 pa2, bf16x8 pa3) {
    const s16x4 l0 = tr_read<v_rd_off(D0, 0, 0)>(vb), h0 = tr_read<v_rd_off(D0, 0, 1)>(vb), l1 = tr_read<v_rd_off(D0, 1, 0)>(vb), h1 = tr_read<v_rd_off(D0, 1, 1)>(vb);
    const s16x4 l2 = tr_read<v_rd_off(D0, 2, 0)>(vb), h2 = tr_read<v_rd_off(D0, 2, 1)>(vb), l3 = tr_read<v_rd_off(D0, 3, 0)>(vb), h3 = tr_read<v_rd_off(D0, 3, 1)>(vb);
    asm volatile("s_waitcnt lgkmcnt(0)" ::: "memory"); SBAR();
#define PK(L, H) (bf16x8){L[0], L[1], L[2], L[3], H[0], H[1], H[2], H[3]}
    od = __builtin_amdgcn_mfma_f32_32x32x16_bf16(pa0, PK(l0, h0), od, 0, 0, 0);
    od = __builtin_amdgcn_mfma_f32_32x32x16_bf16(pa1, PK(l1, h1), od, 0, 0, 0);
    od = __builtin_amdgcn_mfma_f32_32x32x16_bf16(pa2, PK(l2, h2), od, 0, 0, 0);
    od = __builtin_amdgcn_mfma_f32_32x32x16_bf16(pa3, PK(l3, h3), od, 0, 0, 0);
#undef PK
}
__device__ __forceinline__ void pv_d0(f32x16* o, int vb, bf16x8 pa0, bf16x8 pa1, bf16x8 pa2, bf16x8 pa3) {
    pv_one<0>(o[0], vb, pa0, pa1, pa2, pa3); pv_one<1>(o[1], vb, pa0, pa1, pa2, pa3); pv_one<2>(o[2], vb, pa0, pa1, pa2, pa3); pv_one<3>(o[3], vb, pa0, pa1, pa2, pa3);
}
#define PK4(P, BASE, OUT) do { unsigned a0 = cvt_pk_bf16(P[BASE + 0], P[BASE + 1]), a1 = cvt_pk_bf16(P[BASE + 2], P[BASE + 3]);   \
    unsigned b0 = cvt_pk_bf16(P[BASE + 4], P[BASE + 5]), b1 = cvt_pk_bf16(P[BASE + 6], P[BASE + 7]);                              \
    auto r0 = __builtin_amdgcn_permlane32_swap(a0, b0, false, false); auto r1 = __builtin_amdgcn_permlane32_swap(a1, b1, false, false); \
    u32x4 w = {r0[0], r1[0], r0[1], r1[1]}; OUT = __builtin_bit_cast(bf16x8, w); } while (0)

__device__ __forceinline__ void sb_weights(f32x16& p0, f32x16& p1, float& carry, int jb, int qrel, int hi) {
    f32x16 M0, M1;
#pragma unroll
    for (int r = 0; r < 16; ++r) {
        { const float z = __builtin_amdgcn_fmed3f(p0[r] * ATT_C, -60.f, 60.f); const float t = __builtin_amdgcn_exp2f(-z); const float b = __builtin_amdgcn_rcpf(1.0f + t); p0[r] = b; M0[r] = t * b; }
        { const float z = __builtin_amdgcn_fmed3f(p1[r] * ATT_C, -60.f, 60.f); const float t = __builtin_amdgcn_exp2f(-z); const float b = __builtin_amdgcn_rcpf(1.0f + t); p1[r] = b; M1[r] = t * b; }
    }
    if (jb >= 0) {
        const int kb = 64 * jb + 4 * hi;
#pragma unroll
        for (int r = 0; r < 16; ++r) { const int kv = kb + (r & 3) + 8 * (r >> 2);
            if (kv >= qrel) { M0[r] = 1.f; p0[r] = 0.f; }
            if (kv + 32 >= qrel) { M1[r] = 1.f; p1[r] = 0.f; } }
    }
    float glo[8], ghi[8];
#pragma unroll
    for (int g = 0; g < 4; ++g) {
        const float s0 = (M0[4 * g] * M0[4 * g + 1]) * (M0[4 * g + 2] * M0[4 * g + 3]);
        const float s1 = (M1[4 * g] * M1[4 * g + 1]) * (M1[4 * g + 2] * M1[4 * g + 3]);
        auto r0 = __builtin_amdgcn_permlane32_swap(__float_as_uint(s0), __float_as_uint(s0), false, false);
        auto r1 = __builtin_amdgcn_permlane32_swap(__float_as_uint(s1), __float_as_uint(s1), false, false);
        glo[g] = __uint_as_float(r0[0]); ghi[g] = __uint_as_float(r0[1]); glo[4 + g] = __uint_as_float(r1[0]); ghi[4 + g] = __uint_as_float(r1[1]);
    }
    float run = carry;
#pragma unroll
    for (int gi = 7; gi >= 0; --gi) {
        const float base_hi = run; run *= ghi[gi]; const float base_lo = run; run *= glo[gi];
        float a = hi ? base_hi : base_lo;
        if (gi >= 4) { const int g = gi - 4;
            const float w3 = p1[4 * g + 3] * a; a *= M1[4 * g + 3];
            const float w2 = p1[4 * g + 2] * a; a *= M1[4 * g + 2];
            const float w1 = p1[4 * g + 1] * a; a *= M1[4 * g + 1];
            const float w0 = p1[4 * g + 0] * a;
            p1[4 * g + 3] = w3; p1[4 * g + 2] = w2; p1[4 * g + 1] = w1; p1[4 * g + 0] = w0;
        } else { const int g = gi;
            const float w3 = p0[4 * g + 3] * a; a *= M0[4 * g + 3];
            const float w2 = p0[4 * g + 2] * a; a *= M0[4 * g + 2];
            const float w1 = p0[4 * g + 1] * a; a *= M0[4 * g + 1];
            const float w0 = p0[4 * g + 0] * a;
            p0[4 * g + 3] = w3; p0[4 * g + 2] = w2; p0[4 * g + 1] = w1; p0[4 * g + 0] = w0;
        }
    }
    carry = (run < 1.17549435e-38f) ? 0.f : run;
}

struct Stg { bf16x8 v0, v1, k0, k1; };
#define ATT_SLOAD(st, key0) do { st.v0 = *(const bf16x8*)(Vh + (size_t)((key0) + sr) * LDK + sc); st.v1 = *(const bf16x8*)(Vh + (size_t)((key0) + 32 + sr) * LDK + sc); \
    st.k0 = *(const bf16x8*)(Kh + (size_t)((key0) + sr) * LDK + sc); st.k1 = *(const bf16x8*)(Kh + (size_t)((key0) + 32 + sr) * LDK + sc); } while (0)
#define ATT_SWRITE(vbuf, kbuf, st) do { *(LAS bf16x8*)((vbuf) + vst0) = st.v0; *(LAS bf16x8*)((vbuf) + vst1) = st.v1; \
    *(LAS bf16x8*)((kbuf) + KSWZ(sr, sc * 2)) = st.k0; *(LAS bf16x8*)((kbuf) + KSWZ(32 + sr, sc * 2)) = st.k1; } while (0)

template <int LDQ, int LDK, int LDO>
__device__ __forceinline__ void sb_unit(const bf16* __restrict__ Qb, const bf16* __restrict__ Kh, const bf16* __restrict__ Vh, bf16* __restrict__ Ob, int qb, LAS char* lds, LAS unsigned* flg) {
    int tid = threadIdx.x; asm volatile("" : "+v"(tid));
    const int wid = __builtin_amdgcn_readfirstlane(tid >> 6), lane = tid & 63, r32 = lane & 31, hi = lane >> 5;
    LAS char* V_lds = lds; LAS char* K_lds = lds + 2 * SHM_T;
    f32x16 o[4] = {}; bf16x8 qr[8];
    const bf16* Qw = Qb + (size_t)(wid * QBLK + r32) * LDQ + hi * 8;
#pragma unroll
    for (int d0 = 0; d0 < 8; ++d0) qr[d0] = *(const bf16x8*)(Qw + d0 * 16);
    const int sr = tid >> 4, sc = (tid & 15) * 8, vst0 = v_st(sr, sc), vst1 = v_st(32 + sr, sc);
    const int vb0 = (int)(uintptr_t)V_lds + v_rd_base(lane);
    const int NT = 4 * (qb + 1), qrel = wid * QBLK + r32;
    Stg st;
    ATT_SLOAD(st, (NT - 1) * KVBLK); ATT_SWRITE(V_lds, K_lds, st);
    if (NT > 1) ATT_SLOAD(st, (NT - 2) * KVBLK);
    __syncthreads();
    float carry = 1.f; bool wdone = false;
    for (int t = 0; t < NT; ++t) {
        const int buf = t & 1, jt = NT - 1 - t, jb = jt - 4 * qb;
        const bool active = (jb < 0) || (jb * 64 < wid * QBLK + 31);
        if (active && !wdone) {
            f32x16 p0, p1; bf16x8 pa0, pa1, pa2, pa3;
            qkt(p0, p1, K_lds + buf * SHM_T, qr, r32, hi);
            sb_weights(p0, p1, carry, jb, qrel, hi);
            PK4(p0, 0, pa0); PK4(p0, 8, pa1); PK4(p1, 0, pa2); PK4(p1, 8, pa3);
            SBAR();
            pv_d0(o, vb0 + buf * SHM_T, pa0, pa1, pa2, pa3);
        }
        wdone = __all(carry == 0.0f); if (lane == 0) flg[(t & 1) * 8 + wid] = wdone ? 1u : 0u;
        if (t + 1 < NT) ATT_SWRITE(V_lds + (buf ^ 1) * SHM_T, K_lds + (buf ^ 1) * SHM_T, st);
        if (t + 2 < NT) ATT_SLOAD(st, (NT - 3 - t) * KVBLK);
        __syncthreads();
        { const LAS u32x4* f4 = (const LAS u32x4*)(flg + (t & 1) * 8); const u32x4 fa = f4[0], fb = f4[1];
          if ((fa.x & fa.y & fa.z & fa.w & fb.x & fb.y & fb.z & fb.w) != 0u) break; }
    }
    bf16* Ow = Ob + (size_t)(wid * QBLK) * LDO;
#pragma unroll
    for (int r = 0; r < 16; ++r) { const int orow = crow(r, hi);
#pragma unroll
        for (int d0 = 0; d0 < 4; ++d0) Ow[(size_t)orow * LDO + d0 * 32 + r32] = (bf16)(cvt_pk_bf16(o[d0][r], 0.f) & 0xffffu); }
}

template <int LDQ, int LDK, int LDO>
__device__ __forceinline__ void mem_unit(const bf16* __restrict__ Qb0, const bf16* __restrict__ Kh, const bf16* __restrict__ Vh, bf16* __restrict__ Ob0, int nq, LAS char* lds, LAS float* ws) {
    int tid = threadIdx.x; asm volatile("" : "+v"(tid));
    const int wid = __builtin_amdgcn_readfirstlane(tid >> 6), lane = tid & 63, r32 = lane & 31, hi = lane >> 5;
    LAS char* V_lds = lds; LAS char* K_lds = lds + 4 * SHM_T;
    const int sr = tid >> 4, sc = (tid & 15) * 8, vst0 = v_st(sr, sc), vst1 = v_st(32 + sr, sc);
    const int vb0 = (int)(uintptr_t)V_lds + v_rd_base(lane);
#pragma unroll
    for (int t = 0; t < 4; ++t) { Stg st; ATT_SLOAD(st, t * KVBLK); ATT_SWRITE(V_lds + t * SHM_T, K_lds + t * SHM_T, st); }
    __syncthreads();
#pragma unroll 1
    for (int qi = 0; qi < nq; ++qi) {
    const bf16* Qb = Qb0 + (size_t)qi * 256 * LDQ; bf16* Ob = Ob0 + (size_t)qi * 256 * LDO;
    f32x16 o[4] = {}; bf16x8 qr[8];
    const bf16* Qw = Qb + (size_t)(wid * QBLK + r32) * LDQ + hi * 8;
#pragma unroll
    for (int d0 = 0; d0 < 8; ++d0) qr[d0] = *(const bf16x8*)(Qw + d0 * 16);
    float mx = -INFINITY;
#pragma unroll 1
    for (int t = 0; t < 4; ++t) { f32x16 p0, p1; qkt(p0, p1, K_lds + t * SHM_T, qr, r32, hi);
#pragma unroll
        for (int r = 0; r < 16; ++r) mx = fmaxf(mx, fmaxf(p0[r], p1[r])); }
    { auto rr = __builtin_amdgcn_permlane32_swap(__float_as_uint(mx), __float_as_uint(mx), false, false); mx = fmaxf(__uint_as_float(rr[0]), __uint_as_float(rr[1])); }
    const float mC = -mx * ATT_C; float l = 0.f;
#pragma unroll 1
    for (int t = 0; t < 4; ++t) { f32x16 p0, p1; bf16x8 pa0, pa1, pa2, pa3; qkt(p0, p1, K_lds + t * SHM_T, qr, r32, hi);
#pragma unroll
        for (int r = 0; r < 16; ++r) { p0[r] = __builtin_amdgcn_exp2f(fmaf(p0[r], ATT_C, mC)); p1[r] = __builtin_amdgcn_exp2f(fmaf(p1[r], ATT_C, mC)); l += p0[r] + p1[r]; }
        PK4(p0, 0, pa0); PK4(p0, 8, pa1); PK4(p1, 0, pa2); PK4(p1, 8, pa3);
        SBAR();
        pv_d0(o, vb0 + t * SHM_T, pa0, pa1, pa2, pa3); }
    { auto rr = __builtin_amdgcn_permlane32_swap(__float_as_uint(l), __float_as_uint(l), false, false); l = __uint_as_float(rr[0]) + __uint_as_float(rr[1]); }
    if (hi == 0) ws[r32] = l;
    asm volatile("s_waitcnt lgkmcnt(0)" ::: "memory");
    bf16* Ow = Ob + (size_t)(wid * QBLK) * LDO;
#pragma unroll
    for (int r = 0; r < 16; ++r) { const int orow = crow(r, hi); const float rl = __builtin_amdgcn_rcpf(ws[orow]);
#pragma unroll
        for (int d0 = 0; d0 < 4; ++d0) Ow[(size_t)orow * LDO + d0 * 32 + r32] = (bf16)(cvt_pk_bf16(o[d0][r] * rl, 0.f) & 0xffffu); }
    }
    __syncthreads();
}
#undef ATT_SLOAD
#undef ATT_SWRITE
#undef PK4
#undef SBAR
#undef KSWZ
}

#define XB_TMO      128
#define XB_XCNT(j)  (256  + 64 * (j))
#define XB_XSUB(j)  (1280 + 64 * (j))
#define XB_XGEN(j)  (2304 + 64 * (j))
#define XB_TOP      3328
#define XB_TOPGEN   3392
#define XCD_BAR_WORDS 3456
#define XB_SPIN_CAP (1u << 18)
__device__ __forceinline__ unsigned xb_ld(unsigned* p)              { return __hip_atomic_load(p, __ATOMIC_RELAXED, __HIP_MEMORY_SCOPE_AGENT); }
__device__ __forceinline__ unsigned xb_add(unsigned* p, unsigned v) { return __hip_atomic_fetch_add(p, v, __ATOMIC_RELAXED, __HIP_MEMORY_SCOPE_AGENT); }
__device__ __forceinline__ unsigned xb_xcc_id() { return (unsigned)__builtin_amdgcn_s_getreg((3 << 11) | 20) & 0xFu; }
#define XB_SPIN(cond, bar) do { unsigned _sp = 0; while (cond) { __builtin_amdgcn_s_sleep(1); \
    if ((++_sp & 255u) == 0u) { if (xb_ld(&(bar)[XB_TMO])) break; if (_sp > XB_SPIN_CAP) { atomicAdd(&(bar)[XB_TMO], 1u); break; } } } } while (0)
struct XcdBarrier { unsigned* bar; unsigned x; volatile LAS unsigned* st; unsigned members; };
__device__ __forceinline__ XcdBarrier xcd_barrier_post(unsigned* bar, volatile LAS unsigned* st, unsigned members) {
    XcdBarrier b; b.bar = bar; b.x = xb_xcc_id(); b.st = st; b.members = members;
    if (threadIdx.x == 0) (void)xb_add(&bar[XB_XCNT(b.x)], 1u);
    return b;
}
__device__ __forceinline__ void xcd_barrier_complete(unsigned* bar, unsigned x, unsigned& nloc, unsigned& nx, unsigned G) {
    unsigned sum, cnt, mine, sp = 0u;
    for (;;) {
        sum = 0u; cnt = 0u; mine = 0u;
#pragma unroll
        for (unsigned j = 0; j < 16; ++j) { const unsigned c = xb_ld(&bar[XB_XCNT(j)]); sum += c; cnt += (c > 0u) ? 1u : 0u; mine = (j == x) ? c : mine; }
        if (sum == G) break;
        __builtin_amdgcn_s_sleep(1);
        if ((++sp & 255u) == 0u) { if (xb_ld(&bar[XB_TMO])) break; if (sp > XB_SPIN_CAP) { atomicAdd(&bar[XB_TMO], 1u); break; } }
    }
    nloc = mine > 0u ? mine : 1u; nx = cnt > 0u ? cnt : 1u;
}
__device__ __forceinline__ void xcd_barrier(const XcdBarrier& b) {
    asm volatile("s_waitcnt vmcnt(0)" ::: "memory");
    __syncthreads();
    if (threadIdx.x == 0) {
        unsigned* bar = b.bar;
        __builtin_amdgcn_s_waitcnt(0);
        unsigned nloc = b.st[0], nx = b.st[1];
        if (nloc == 0u) { xcd_barrier_complete(bar, b.x, nloc, nx, b.members); b.st[0] = nloc; b.st[1] = nx; }
        const unsigned old = xb_add(&bar[XB_XSUB(b.x)], 1u);
        const unsigned gen = old / nloc;
        if (old + 1u == (gen + 1u) * nloc) {
            __builtin_amdgcn_fence(__ATOMIC_RELEASE, "agent");
            asm volatile("s_waitcnt vmcnt(0)" ::: "memory");
            const unsigned og = xb_add(&bar[XB_TOP], 1u);
            const unsigned tg = og / nx;
            if (og + 1u == (tg + 1u) * nx) xb_add(&bar[XB_TOPGEN], 1u);
            else XB_SPIN(xb_ld(&bar[XB_TOPGEN]) == tg, bar);
            __builtin_amdgcn_fence(__ATOMIC_ACQUIRE, "agent");
            xb_add(&bar[XB_XGEN(b.x)], 1u);
            asm volatile("s_waitcnt vmcnt(0)" ::: "memory");
        } else {
            XB_SPIN(xb_ld(&bar[XB_XGEN(b.x)]) == gen, bar);
            __builtin_amdgcn_fence(__ATOMIC_ACQUIRE, "agent");
            asm volatile("s_waitcnt vmcnt(0)" ::: "memory");
        }
    }
    __syncthreads();
}

__device__ __forceinline__ float wave_sum(float v) {
#pragma unroll
    for (int o = 1; o < 64; o <<= 1) v += __shfl_xor(v, o);
    return v;
}
__device__ __forceinline__ int gated_row(int n, int H) { const int second = n >= H, f = second ? n - H : n; return (f >> 7) * 256 + ((f >> 5) & 3) * 64 + second * 32 + (f & 31); }
__device__ __forceinline__ void transpose_item(const float* __restrict__ W, int N, bf16* __restrict__ WT, int ld, int koff, int HG, LAS float* scr, int item, int lane) {
    const int nblk = N / 32, kb = item / nblk, nb = item % nblk, k0 = 64 * kb, n0 = 32 * nb;
    { f32x4 v[8]; const int kr = lane >> 3, n4 = (lane & 7) * 4;
#pragma unroll
      for (int i = 0; i < 8; ++i) v[i] = *(const f32x4*)(W + (size_t)(k0 + kr + 8 * i) * N + n0 + n4);
#pragma unroll
      for (int i = 0; i < 8; ++i) { LAS float* d = scr + (kr + 8 * i) * 33 + n4; d[0] = v[i][0]; d[1] = v[i][1]; d[2] = v[i][2]; d[3] = v[i][3]; } }
    asm volatile("s_waitcnt lgkmcnt(0)" ::: "memory");
    const int c = lane & 7;
#pragma unroll
    for (int j = 0; j < 4; ++j) { const int n = (lane >> 3) + 8 * j; const LAS float* s = scr + (8 * c) * 33 + n;
        u32x4 o; o.x = cvt_pk_w7(s[0 * 33], s[1 * 33]); o.y = cvt_pk_w7(s[2 * 33], s[3 * 33]); o.z = cvt_pk_w7(s[4 * 33], s[5 * 33]); o.w = cvt_pk_w7(s[6 * 33], s[7 * 33]);
        const int drow = HG ? gated_row(n0 + n, HG) : (n0 + n);
        *(u32x4*)(WT + (size_t)drow * ld + koff + k0 + 8 * c) = o; }
    asm volatile("s_waitcnt lgkmcnt(0)" ::: "memory");
}

struct Args { const float* in[24]; float* out; unsigned char* ws; int ph_lo, ph_hi; };

constexpr int NWAVES = 8;
constexpr int PH_PER_LAYER = 12, N_PHASES = 2 + PH_PER_LAYER * DEPTH;

__global__ void __launch_bounds__(NWAVES * 64, 2) hybrid_fwd(Args args) {
    extern __shared__ __attribute__((aligned(16))) unsigned char lds_raw[];
    LAS unsigned char* lds = (LAS unsigned char*)lds_raw;
    volatile LAS unsigned* MISC = (volatile LAS unsigned*)(lds + MISC_OFF);
    const int tid = threadIdx.x, wave = __builtin_amdgcn_readfirstlane(tid >> 6);
    const int G = gridDim.x, bx = blockIdx.x;
    const int vcu = (G % 8 == 0) ? (bx % 8) * (G / 8) + bx / 8 : bx;
    const int gw = vcu * NWAVES + wave, NGW = G * NWAVES;
    const int NGT = G * NWAVES * 64;
#define FRESH_IDS() int tid_ = threadIdx.x; asm volatile("" : "+v"(tid_)); const int lane = tid_ & 63; const int gt = bx * (NWAVES * 64) + tid_; (void)lane; (void)gt
    unsigned char* ws = args.ws;
    unsigned* ctl = (unsigned*)(ws + WS_CTL);
    for (int u = tid; u < 128; u += NWAVES * 64) ((LAS unsigned*)(lds + MISC_OFF))[u] = 0u;
    __syncthreads();
    XcdBarrier bar = xcd_barrier_post(ctl + CW_BAR, MISC + 8, (unsigned)G);
    const bool use_grp = (G % 8 == 0) && ((M / 8) % (NGW / 8) == 0);
    XcdBarrier gbar = bar; if (use_grp) gbar = xcd_barrier_post(ctl + CW_GBAR + (bx % 8) * 4096, MISC + 12, (unsigned)(G / 8));
    const int lo = args.ph_lo, hi = args.ph_hi;
#ifndef PH_EN
#define PH_EN 0xFFFFu
#endif
#define IN(k) (lo <= (k) && (k) < hi)
#define INL(j) (((PH_EN >> (j)) & 1u) && IN(P + (j)))
#define INP(j) (((PH_EN >> (12 + (j))) & 1u) && IN(j))
#define SEAM(k) do { if (IN(k) && IN((k) + 1)) xcd_barrier(bar); } while (0)
#define GSEAM(k) do { if (IN(k) && IN((k) + 1)) xcd_barrier(gbar); } while (0)

    bf16* BT_IN = (bf16*)(ws + WS_BT_IN); bf16* BT_CAT = (bf16*)(ws + WS_BT_CAT); bf16* BT_GLU = (bf16*)(ws + WS_BT_GLU); bf16* BT_KV = (bf16*)(ws + WS_BT_KV);
    bf16* BT_O = (bf16*)(ws + WS_BT_O); bf16* BT_GU = (bf16*)(ws + WS_BT_GU); bf16* BT_DN = (bf16*)(ws + WS_BT_DN); bf16* BT_S1 = (bf16*)(ws + WS_BT_S1); bf16* BT_S2 = (bf16*)(ws + WS_BT_S2);
    float* KC = (float*)(ws + WS_KC); f32x2* LP = (f32x2*)(ws + WS_LP); f32x2* CF = (f32x2*)(ws + WS_CF); f32x2* STAT = (f32x2*)(ws + WS_STAT);
    bf16* XB = (bf16*)(ws + WS_XB); bf16* QKV = (bf16*)(ws + WS_QKV); unsigned char* GATES = (unsigned char*)(ws + WS_GATES); bf16* HID = (bf16*)(ws + WS_HID); bf16* QM = (bf16*)(ws + WS_QM);
    bf16* A2 = (bf16*)(ws + WS_A2); float* SS = (float*)(ws + WS_S); bf16* KVM = (bf16*)(ws + WS_KVM); bf16* MEMB = (bf16*)(ws + WS_MEMB); bf16* ACAT = (bf16*)(ws + WS_ACAT);
    bf16* GBUF = (bf16*)(ws + WS_GBUF); bf16* MERGED = (bf16*)(ws + WS_MERGED); bf16* BT_KV4 = (bf16*)(ws + WS_BT_KV4); bf16* KVM4 = (bf16*)(ws + WS_KVM4); _Float16* PRE = (_Float16*)(ws + WS_PRE);
    float* OUT = args.out;

    if (INP(0)) { FRESH_IDS();
        for (int idx = gt; idx < DEPTH * NG * NP; idx += NGT) {
            const int lg = idx >> 6, p = idx & 63;
            const float lre = args.in[5][idx], lim = args.in[6][idx], dt = expf(args.in[7][lg]);
            const float a = lre * dt, b = lim * dt;
            for (int tau = 0; tau <= TCH; ++tau) { const float mg = expf(a * (float)tau); float sn, cs; sincosf(b * (float)tau, &sn, &cs); LP[(size_t)(lg * 33 + tau) * 64 + p] = (f32x2){mg * cs, mg * sn}; }
            float sn, cs, sh, ch; sincosf(b, &sn, &cs); sincosf(0.5f * b, &sh, &ch); (void)ch;
            const float nr = expm1f(a) * cs - 2.0f * sh * sh, ni = expf(a) * sn;
            const float den = 1.0f / (lre * lre + lim * lim);
            CF[idx] = (f32x2){(nr * lre + ni * lim) * den, (ni * lre - nr * lim) * den};
        }
    }
    if (INP(0)) { FRESH_IDS();
        LAS float* scr = (LAS float*)(lds + wave * 16384);
        constexpr int I_KV1 = (DM / 64) * (1024 / 32);
        for (int it = gw; it < DEPTH * I_KV1; it += NGW) { const int ll = it / I_KV1, r = it - ll * I_KV1;
            transpose_item(args.in[15] + (size_t)ll * DM * 1024, 1024, BT_KV4 + (size_t)ll * 1024 * DM, DM, 0, 0, scr, r, lane); }
        const float* mem = args.in[1];
        for (size_t ch = gt; ch < (size_t)BATCH * MEMT * DM / 8; ch += NGT) { const f32x4 a = *(const f32x4*)(mem + ch * 8), b = *(const f32x4*)(mem + ch * 8 + 4); *(u32x4*)(MEMB + ch * 8) = pack8(a, b); }
    }
    SEAM(0);
    if (INP(1)) { FRESH_IDS();
        for (int idx = gt; idx < DEPTH * NG * TCH * 256; idx += NGT) {
            const int cp = idx & 15, c = (idx >> 4) & 15, tau = (idx >> 8) & 31, lg = idx >> 13;
            const float* cre = args.in[10] + (size_t)(lg * 16 + c) * 64; const float* cim = args.in[11] + (size_t)(lg * 16 + c) * 64;
            const float* bre = args.in[8] + (size_t)lg * 64 * 16 + cp; const float* bim = args.in[9] + (size_t)lg * 64 * 16 + cp;
            const f32x2* lp = LP + (size_t)(lg * 33 + tau) * 64; const f32x2* cf = CF + (size_t)lg * 64;
            float s = 0.f;
            for (int p = 0; p < 64; ++p) {
                const f32x2 w = lp[p], f = cf[p]; const float wr_ = w.x * f.x - w.y * f.y, wi_ = w.x * f.y + w.y * f.x;
                const float br = bre[p * 16], bi = bim[p * 16]; const float xr = wr_ * br - wi_ * bi, xi = wr_ * bi + wi_ * br;
                s += cre[p] * xr - cim[p] * xi;
            }
            KC[idx] = s;
        }
    }
    if (INP(1)) {
        pg8::Gemm g{MEMB, BT_KV4, DM, DM}; pg8::StaticOrder S; S.init(BATCH * MEMT, DEPTH * 1024, DM, G, bx);
        pg8::EpiStoreBf16 E{KVM4, DEPTH * 1024};
        pg8::gemm_phase(lds, g, S, E);
    }
    SEAM(1);

#define LN_PHASE(gam, bet, FINAL) do { \
            f32x4 gv[4][2], bv[4][2]; \
            _Pragma("unroll") for (int j = 0; j < 4; ++j) _Pragma("unroll") for (int n = 0; n < 2; ++n) { gv[j][n] = *((const f32x4*)(gam) + (lane + 64 * j) * 2 + n); bv[j][n] = *((const f32x4*)(bet) + (lane + 64 * j) * 2 + n); } \
              \
            const bool xl_ = (G % 8 == 0) && ((M / 8) % (NGW / 8) == 0); const int cnt_ = xl_ ? (M / 8) / (NGW / 8) : (M - gw + NGW - 1) / NGW; \
            for (int i_ = 0; i_ < cnt_; ++i_) { const int m = xl_ ? (vcu / (G / 8)) * (M / 8) + (cnt_ - 1 - i_) * (NGW / 8) + (gw % (NGW / 8)) : gw + i_ * NGW; \
                const h16x8* xr = (const h16x8*)(PRE + (size_t)m * DM) + lane; f32x8 v[4]; float s = 0.f; \
                _Pragma("unroll") for (int j = 0; j < 4; ++j) { v[j] = __builtin_convertvector(xr[64 * j], f32x8); s += ((v[j][0] + v[j][1]) + (v[j][2] + v[j][3])) + ((v[j][4] + v[j][5]) + (v[j][6] + v[j][7])); } \
                const float mean = wave_sum(s) * (1.f / DM); float s2 = 0.f; \
                _Pragma("unroll") for (int j = 0; j < 4; ++j) { v[j] = v[j] - mean; const f32x8 q = v[j] * v[j]; s2 += ((q[0] + q[1]) + (q[2] + q[3])) + ((q[4] + q[5]) + (q[6] + q[7])); } \
                const float rstd = 1.f / sqrtf(wave_sum(s2) * (1.f / DM) + LN_EPS); \
                if (FINAL) { f32x4* o4 = (f32x4*)(OUT + (size_t)m * DM) + lane * 2; \
                    _Pragma("unroll") for (int j = 0; j < 4; ++j) { const f32x4 a = {v[j][0], v[j][1], v[j][2], v[j][3]}, b = {v[j][4], v[j][5], v[j][6], v[j][7]}; \
                        o4[128 * j] = a * rstd * gv[j][0] + bv[j][0]; o4[128 * j + 1] = b * rstd * gv[j][1] + bv[j][1]; } } \
                else { if (lane == 0) STAT[m] = (f32x2){mean, rstd}; \
                    u32x4* o8 = (u32x4*)(XB + (size_t)m * DM) + lane; \
                    _Pragma("unroll") for (int j = 0; j < 4; ++j) { const f32x4 a = {v[j][0], v[j][1], v[j][2], v[j][3]}, b = {v[j][4], v[j][5], v[j][6], v[j][7]}; \
                        o8[64 * j] = pack8_w7(a * rstd * gv[j][0] + bv[j][0], b * rstd * gv[j][1] + bv[j][1]); } } \
            } } while (0)
#define CUR(p) ((bf16*)((unsigned char*)(p) + dcur))
#define NXT(p) ((bf16*)((unsigned char*)(p) + dnxt))
#pragma unroll 1
    for (int l = -1; l < DEPTH; ++l) {
        const int P = (l >= 0) ? 2 + PH_PER_LAYER * l : -1000, lq = (l >= 0) ? l : 0, lc = l + 1;
        const size_t dcur = (lq & 1) ? WS_ALT_DELTA : 0, dnxt = (lc & 1) ? WS_ALT_DELTA : 0;
        const float* b_in = args.in[3] + (size_t)lq * INW;
        if (INL(0) && l > 0) { FRESH_IDS(); LN_PHASE(args.in[22] + (size_t)(l - 1) * DM, args.in[23] + (size_t)(l - 1) * DM, false); }
        SEAM(P + 0);
        if (INL(1)) {
            { pg8::Gemm g{XB, CUR(BT_IN), DM, DM}; pg8::StaticOrder S; S.init(M, INW, DM, G, bx);
              pg8::EpiInProj E{b_in, QKV, A2, QM, GATES};
              pg8::gemm_phase(lds, g, S, E); }
        }
        if (IN(P + 1) && IN(P + 4)) xcd_barrier(bar);
        { const bool conv_on = (lc < DEPTH) && ((PH_EN >> 0) & 1u) && (l < 0 ? IN(2) : IN(P + 4)), mix_on = INL(4);
          int par = (l >= 0) ? (vcu & 1) : 0; par = __builtin_amdgcn_readfirstlane(par); asm volatile("" : "+s"(par));
#pragma unroll 1
          for (int pass = 0; pass < 2; ++pass) {
            if (pass == par) { if (conv_on) { FRESH_IDS();
            const float* w_inc = args.in[2] + (size_t)lc * DM * INW;
            LAS float* scr = (LAS float*)(lds + wave * 16384);
            constexpr int I_IN = (DM / 64) * (INW / 32), I_SB = (SBW / 64) * (DM / 32), I_SS = (SSMW / 64) * (DM / 32), I_MM = (MEMW / 64) * (DM / 32), I_GL = (SSMW / 64) * (1024 / 32),
                          I_O = (DM / 64) * (DM / 32), I_GU = (DM / 64) * (2 * DFF / 32), I_DN = (DFF / 64) * (DM / 32);
            constexpr int NITEMS = I_IN + I_SB + I_SS + I_MM + I_GL + I_O + I_GU + I_DN;
            for (int it = gw; it < NITEMS; it += NGW) {
                int r = it; const float* W; bf16* WT; int N, ld, koff = 0, HG = 0;
                if (r < I_IN) { W = w_inc; N = INW; WT = NXT(BT_IN); ld = DM; }
                else if ((r -= I_IN) < I_SB) { W = args.in[4] + (size_t)lc * SBW * DM; N = DM; WT = NXT(BT_CAT); ld = DM; }
                else if ((r -= I_SB) < I_SS) { W = args.in[14] + (size_t)lc * SSMW * DM; N = DM; WT = NXT(BT_CAT); ld = DM; koff = 1024; }
                else if ((r -= I_SS) < I_MM) { W = args.in[16] + (size_t)lc * MEMW * DM; N = DM; WT = NXT(BT_CAT); ld = DM; koff = 1536; }
                else if ((r -= I_MM) < I_GL) { W = args.in[13] + (size_t)lc * SSMW * 1024; N = 1024; WT = NXT(BT_GLU); ld = SSMW; HG = 512; }
                else if ((r -= I_GL) < I_O) { W = args.in[17] + (size_t)lc * DM * DM; N = DM; WT = NXT(BT_O); ld = DM; }
                else if ((r -= I_O) < I_GU) { W = args.in[20] + (size_t)lc * DM * 2 * DFF; N = 2 * DFF; WT = NXT(BT_GU); ld = DM; HG = DFF; }
                else { r -= I_GU; W = args.in[21] + (size_t)lc * DFF * DM; N = DM; WT = NXT(BT_DN); ld = DFF; }
                transpose_item(W, N, WT, ld, koff, HG, scr, r, lane);
            }
            for (int ch = gt; ch < NG * 512 * 80; ch += NGT) {
                const int kc = ch % 80, n = (ch / 80) & 511, g = ch / (80 * 512), i = n >> 4, c = n & 15, lg = lc * NG + g, kk0 = kc * 8;
                f32x4 v0 = {0.f, 0.f, 0.f, 0.f}, v1 = v0;
                if (kk0 < 512) { const int s = kk0 >> 4, cp0 = kk0 & 15;
                    if (s <= i) { const float* src = KC + ((size_t)(lg * 32 + (i - s)) * 16 + c) * 16 + cp0; v0 = *(const f32x4*)src; v1 = *(const f32x4*)(src + 4); } }
                else { const int p0 = (kk0 - 512) & 63; const bool im = (kk0 - 512) >= 64;
                    const float* cre = args.in[10] + (size_t)(lg * 16 + c) * 64 + p0; const float* cim = args.in[11] + (size_t)(lg * 16 + c) * 64 + p0; const f32x2* lp = LP + (size_t)(lg * 33 + i + 1) * 64 + p0;
#pragma unroll
                    for (int e = 0; e < 8; ++e) { const f32x2 w = lp[e]; const float val = im ? -(cre[e] * w.y + cim[e] * w.x) : (cre[e] * w.x - cim[e] * w.y); if (e < 4) v0[e] = val; else v1[e - 4] = val; } }
                *(u32x4*)(NXT(BT_S2) + ((size_t)(g * 512 + n) * K2 + kk0)) = pack8(v0, v1);
            }
            for (int ch = gt; ch < NG * 256 * 64; ch += NGT) {
                const int kc = ch & 63, j = (ch >> 6) & 255, g = ch >> 14, lg = lc * NG + g, kk0 = kc * 8, s = kk0 >> 4, cp0 = kk0 & 15;
                f32x4 v0 = {0.f, 0.f, 0.f, 0.f}, v1 = v0;
                if (j < 128) { const int p = j & 63; const bool im = j >= 64;
                    const f32x2 w = LP[(size_t)(lg * 33 + (TCH - 1 - s)) * 64 + p], f = CF[(size_t)lg * 64 + p]; const float wr_ = w.x * f.x - w.y * f.y, wi_ = w.x * f.y + w.y * f.x;
                    const float* bre = args.in[8] + ((size_t)lg * 64 + p) * 16 + cp0; const float* bim = args.in[9] + ((size_t)lg * 64 + p) * 16 + cp0;
#pragma unroll
                    for (int e = 0; e < 8; ++e) { const float val = im ? (wr_ * bim[e] + wi_ * bre[e]) : (wr_ * bre[e] - wi_ * bim[e]); if (e < 4) v0[e] = val; else v1[e - 4] = val; } }
                *(u32x4*)(NXT(BT_S1) + ((size_t)(g * 256 + j) * 512 + kk0)) = pack8(v0, v1);
            }
            if (lc == 0) {
                const float* x = args.in[0];
                size_t ch = gt;
                for (; ch + (size_t)3 * NGT < (size_t)M * DM / 8; ch += (size_t)4 * NGT) {
                    f32x4 a[4], b[4];
#pragma unroll
                    for (int q = 0; q < 4; ++q) { a[q] = *(const f32x4*)(x + (ch + (size_t)q * NGT) * 8); b[q] = *(const f32x4*)(x + (ch + (size_t)q * NGT) * 8 + 4); }
#pragma unroll
                    for (int q = 0; q < 4; ++q) *(u32x4*)(XB + (ch + (size_t)q * NGT) * 8) = pack8(a[q], b[q]); }
                for (; ch < (size_t)M * DM / 8; ch += NGT) { const f32x4 a = *(const f32x4*)(x + ch * 8), b = *(const f32x4*)(x + ch * 8 + 4); *(u32x4*)(XB + ch * 8) = pack8(a, b); }
            }
            __syncthreads(); } }
            else if (mix_on) {
            if (vcu < 128) {
                { pg8::Gemm g{A2, CUR(BT_S1), K2, 512}; pg8::S5Order1 S{G, vcu}; pg8::EpiS1 E{SS};
                  pg8::gemm_phase(lds, g, S, E); }
                asm volatile("s_waitcnt vmcnt(0)" ::: "memory"); __syncthreads();
                { FRESH_IDS();
                  if (wave < 2) for (int L = vcu; L < 128; L += G) {
                    const int g = L >> 2, b = (L & 3) * 2 + wave, lg = l * NG + g, p = lane;
                    const f32x2 a = LP[(size_t)(lg * 33 + TCH) * 64 + p];
                    float hr = 0.f, hi_ = 0.f;
                    const size_t R0 = (size_t)g * ROWS_G + b * NCH;
                    const float* sp = SS + R0 * 128 + p; bf16* dp = A2 + R0 * K2 + 512 + p;
#pragma unroll 1
                    for (int k0 = 0; k0 < NCH; k0 += 32) {
                        float sr_[32], si_[32];
#pragma unroll
                        for (int i = 0; i < 32; ++i) { sr_[i] = sp[(size_t)(k0 + i) * 128]; si_[i] = sp[(size_t)(k0 + i) * 128 + 64]; }
                        asm volatile("" ::: "memory");
#pragma unroll
                        for (int i = 0; i < 32; ++i) {
                            bf16* dst = dp + (size_t)(k0 + i) * K2;
                            dst[0] = (bf16)(cvt_pk_bf16(hr, 0.f) & 0xffffu); dst[64] = (bf16)(cvt_pk_bf16(hi_, 0.f) & 0xffffu);
                            const float nr = a.x * hr - a.y * hi_ + sr_[i], ni = a.x * hi_ + a.y * hr + si_[i];
                            hr = nr; hi_ = ni;
                        }
                    }
                  } }
                asm volatile("s_waitcnt vmcnt(0)" ::: "memory"); __syncthreads();
                { pg8::Gemm g{A2, CUR(BT_S2), K2, K2}; pg8::S5Order2L S{G, vcu}; pg8::EpiS2 E{A2, args.in[12] + (size_t)l * SSMW, GBUF};
                  pg8::gemm_phase(lds, g, S, E); }
            }
            for (int o = vcu; o < 256; o += G) {
                const int s0 = (o < 128) ? 2 * o : 256 + 6 * (o - 128), ns = (o < 128) ? 2 : 6;
                for (int j = 0; j < ns; ++j) {
                    const int su = s0 + j, bh = su >> 4, qb = su & 15, b = bh >> 3, h = bh & 7;
                    const size_t row0 = (size_t)b * SEQ;
                    att::sb_unit<3072, 3072, 2048>(QKV + (row0 + qb * 256) * 3072 + h * 128, QKV + row0 * 3072 + 1024 + h * 128, QKV + row0 * 3072 + 2048 + h * 128,
                                                    ACAT + (row0 + qb * 256) * 2048 + h * 128, qb, (LAS char*)lds, (LAS unsigned*)(lds + ATTFLG_OFF));
                }
            }
            for (int u = vcu; u < 256; u += G) {
                const int b = u >> 5, h = (u >> 3) & 3, qb = (u & 7) * 2;
                const size_t row0 = (size_t)b * SEQ + qb * 256;
                att::mem_unit<512, DEPTH * 1024, 2048>(QM + row0 * 512 + h * 128, KVM4 + (size_t)b * MEMT * DEPTH * 1024 + l * 1024 + h * 128, KVM4 + (size_t)b * MEMT * DEPTH * 1024 + l * 1024 + 512 + h * 128,
                                                ACAT + row0 * 2048 + 1536 + h * 128, 2, (LAS char*)lds, (LAS float*)(lds + ATTWS_OFF) + wave * 64);
            }
            __syncthreads(); }
          } }
        SEAM(P + 4);
        if (INL(5)) {
            pg8::Gemm g{GBUF, CUR(BT_GLU), SSMW, SSMW}; pg8::StaticOrder S; S.init(M, 1024, SSMW, G, bx); pg8::EpiGated<1> E{ACAT + 1024, 2048};
            pg8::gemm_phase(lds, g, S, E);
        }
        GSEAM(P + 5);
        if (INL(6)) {
            pg8::Gemm g{ACAT, CUR(BT_CAT), DM, DM}; pg8::MergeOrder S; S.init(M, DM, G, bx); pg8::EpiMerge E{GATES, MERGED};
            pg8::gemm_phase(lds, g, S, E);
        }
        GSEAM(P + 6);
        if (INL(7)) {
            pg8::Gemm g{MERGED, CUR(BT_O), DM, DM}; pg8::StaticOrder S; S.init(M, DM, DM, G, bx); pg8::EpiRes E{l == 0 ? args.in[0] : nullptr, PRE, STAT, args.in[22] + (size_t)(l > 0 ? l - 1 : 0) * DM, args.in[23] + (size_t)(l > 0 ? l - 1 : 0) * DM};
            pg8::gemm_phase(lds, g, S, E);
        }
        GSEAM(P + 7);
        if (INL(8)) { FRESH_IDS(); LN_PHASE(args.in[18] + (size_t)l * DM, args.in[19] + (size_t)l * DM, false); }
        SEAM(P + 8);
        if (INL(9)) {
            pg8::Gemm g{XB, CUR(BT_GU), DM, DM}; pg8::StaticOrder S; S.init(M, 2 * DFF, DM, G, bx); pg8::EpiGated<0> E{HID, DFF};
            pg8::gemm_phase(lds, g, S, E);
        }
        GSEAM(P + 9);
        if (INL(10)) {
            pg8::Gemm g{HID, CUR(BT_DN), DFF, DFF}; pg8::StaticOrder S; S.init(M, DM, DFF, G, bx); pg8::EpiRes E{nullptr, PRE, STAT, args.in[18] + (size_t)l * DM, args.in[19] + (size_t)l * DM};
            pg8::gemm_phase(lds, g, S, E);
        }
        if (l == DEPTH - 1) { GSEAM(P + 10); if (INL(11)) { FRESH_IDS(); LN_PHASE(args.in[22] + (size_t)l * DM, args.in[23] + (size_t)l * DM, true); } }
        else if (IN(P + 10) && IN(P + 12)) xcd_barrier(gbar);
    }
#undef IN
#undef SEAM
}

#ifndef MK_SPLIT
#define MK_SPLIT 0
#endif
extern "C" void kernel_launch(void* const* d_in, const int* in_sizes, int n_in, void* d_out, int out_size, void* d_ws, size_t ws_size, hipStream_t stream) {
    static int grid = 0;
    if (grid == 0) {
        if (n_in != 24 || in_sizes[0] != M * DM || out_size != M * DM || ws_size < WS_END) { fprintf(stderr, "kernel_launch: shape mismatch (n_in %d, in0 %d, out %d, ws %zu, need %zu)\n", n_in, n_in > 0 ? in_sizes[0] : -1, out_size, ws_size, (size_t)WS_END); grid = -1; return; }
        int dev = 0, cus = 0, per_cu = 0;
        if (hipGetDevice(&dev) != hipSuccess || hipDeviceGetAttribute(&cus, hipDeviceAttributeMultiprocessorCount, dev) != hipSuccess) { grid = -1; return; }
        if (hipFuncSetAttribute((const void*)hybrid_fwd, hipFuncAttributeMaxDynamicSharedMemorySize, LDS_BYTES) != hipSuccess) { fprintf(stderr, "kernel_launch: hipFuncSetAttribute failed\n"); grid = -1; return; }
        if (hipOccupancyMaxActiveBlocksPerMultiprocessor(&per_cu, (const void*)hybrid_fwd, NWAVES * 64, LDS_BYTES) != hipSuccess || per_cu < 1) { fprintf(stderr, "kernel_launch: occupancy query reports %d\n", per_cu); }
        (void)hipGetLastError();
        grid = cus;
    }
    if (grid < 0) return;
    if (hipMemsetAsync((char*)d_ws + WS_CTL, 0, CTL_ZERO_BYTES, stream) != hipSuccess) return;
    Args a{};
    for (int i = 0; i < 24; ++i) a.in[i] = (const float*)d_in[i];
    a.out = (float*)d_out; a.ws = (unsigned char*)d_ws;
#if MK_SPLIT
    for (int p = 0; p < N_PHASES; ++p) { a.ph_lo = p; a.ph_hi = p + 1; hipLaunchKernelGGL(hybrid_fwd, dim3(grid), dim3(NWAVES * 64), LDS_BYTES, stream, a); }
#else
    a.ph_lo = 0; a.ph_hi = N_PHASES;
    hipLaunchKernelGGL(hybrid_fwd, dim3(grid), dim3(NWAVES * 64), LDS_BYTES, stream, a);
#endif
    const hipError_t le = hipPeekAtLastError();
    if (le != hipSuccess) fprintf(stderr, "kernel_launch: launch failed: %s\n", hipGetErrorName(le));
}
```

```cpp
#include <hip/hip_runtime.h>
#include <cstdio>
#include <cstdint>

#define LAS __attribute__((address_space(3)))
#define GAS __attribute__((address_space(1)))
typedef unsigned short bf16;
typedef short bf16x8 __attribute__((ext_vector_type(8)));
typedef short s16x4 __attribute__((ext_vector_type(4)));
typedef float f32x2 __attribute__((ext_vector_type(2)));
typedef float f32x4 __attribute__((ext_vector_type(4)));
typedef float f32x16 __attribute__((ext_vector_type(16)));
typedef unsigned u32x2 __attribute__((ext_vector_type(2)));
typedef unsigned u32x4 __attribute__((ext_vector_type(4)));
typedef _Float16 h16x8 __attribute__((ext_vector_type(8)));
typedef float f32x8 __attribute__((ext_vector_type(8)));

constexpr int BATCH = 8, SEQ = 4096, DM = 2048, DEPTH = 4, M = BATCH * SEQ;
constexpr int SBW = 1024, SSMW = 512, MEMW = 512, INW = 10240, DFF = 5632, MEMT = 256;
constexpr int NG = 32, NP = 64, TCH = 32, NCH = SEQ / TCH, ROWS_G = BATCH * NCH  , K2 = TCH * 16 + 128  ;
constexpr float DN_ALPHA = 1.681792830507429f;
constexpr float LN_EPS = 1e-5f;
constexpr float LOG2E = 1.4426950408889634f;
constexpr float ATT_C = 0.08838834764831845f * 1.4426950408889634f;

constexpr size_t MiB = 1u << 20;
constexpr size_t WS_CTL = 0, CTL_ZERO_BYTES = 1 * MiB;
constexpr size_t WS_BT_IN = 1 * MiB;
constexpr size_t WS_BT_CAT = WS_BT_IN + 40 * MiB;
constexpr size_t WS_BT_GLU = WS_BT_CAT + 8 * MiB;
constexpr size_t WS_BT_KV = WS_BT_GLU + 1 * MiB;
constexpr size_t WS_BT_O = WS_BT_KV + 4 * MiB;
constexpr size_t WS_BT_GU = WS_BT_O + 8 * MiB;
constexpr size_t WS_BT_DN = WS_BT_GU + 44 * MiB;
constexpr size_t WS_BT_S1 = WS_BT_DN + 22 * MiB;
constexpr size_t WS_BT_S2 = WS_BT_S1 + 8 * MiB;
constexpr size_t WS_KC = WS_BT_S2 + 20 * MiB;
constexpr size_t WS_LP = WS_KC + 4 * MiB;
constexpr size_t WS_CF = WS_LP + 2304 * 1024;
constexpr size_t WS_STAT = WS_CF + 128 * 1024;
constexpr size_t WS_XB = WS_LP + 3 * MiB;
constexpr size_t WS_QKV = WS_XB + 128 * MiB;
constexpr size_t WS_GATES = WS_QKV + 192 * MiB;
constexpr size_t WS_HID = WS_QKV;
constexpr size_t WS_QM = WS_GATES + 384 * MiB;
constexpr size_t WS_A2 = WS_QM + 32 * MiB;
constexpr size_t WS_S = WS_A2 + 40 * MiB;
constexpr size_t WS_KVM = WS_S + 16 * MiB;
constexpr size_t WS_MEMB = WS_KVM + 4 * MiB;
constexpr size_t WS_ACAT = WS_MEMB + 8 * MiB;
constexpr size_t WS_GBUF = WS_ACAT + 128 * MiB;
constexpr size_t WS_MERGED = WS_XB;
constexpr size_t WS_BT_KV4 = WS_GBUF + 32 * MiB;
constexpr size_t WS_KVM4 = WS_BT_KV4 + 16 * MiB;
constexpr size_t WS_PRE = WS_KVM4 + 16 * MiB;
constexpr size_t WS_END = WS_PRE + 128 * MiB;
static_assert(WS_HID + (size_t)M * DFF * 2 <= WS_QM, "hid overlay");
constexpr size_t WS_ALT_DELTA = (WS_GATES + 192 * MiB) - WS_BT_IN;
static_assert(WS_GATES + 192 * MiB >= WS_HID + (size_t)M * DFF * 2 && WS_GATES + 192 * MiB + (WS_KC - WS_BT_IN) <= WS_QM, "second weight copy");
static_assert((size_t)4 * 32 * 33 * 64 * 8 <= 2304 * 1024 && (size_t)4 * 32 * 64 * 8 <= 128 * 1024 && WS_STAT + (size_t)M * 8 <= WS_XB, "LP/CF/STAT");

constexpr int CW_BAR = 4096;
constexpr int CW_GBAR = 8192;

constexpr int RING_BYTES = 131072;
constexpr int MISC_OFF = RING_BYTES;
constexpr int ATTWS_OFF = RING_BYTES + 512;
constexpr int ATTFLG_OFF = ATTWS_OFF + 2048;
constexpr int LDS_BYTES = 147456;

typedef __bf16 bf16x2_t __attribute__((ext_vector_type(2)));
__device__ __forceinline__ unsigned cvt_pk_bf16(float lo, float hi) { f32x2 v = {lo, hi}; bf16x2_t b = __builtin_convertvector(v, bf16x2_t); return __builtin_bit_cast(unsigned, b); }
__device__ __forceinline__ unsigned rne_w7(float v) { const unsigned u = __float_as_uint(v); return (u + 0xFFFFu + ((u >> 17) & 1u)) & 0xFFFE0000u; }
__device__ __forceinline__ unsigned cvt_pk_w7(float lo, float hi) { return (rne_w7(lo) >> 16) | rne_w7(hi); }
__device__ __forceinline__ float bf_lo(unsigned w) { return __uint_as_float(w << 16); }
__device__ __forceinline__ float bf_hi(unsigned w) { return __uint_as_float(w & 0xffff0000u); }
__device__ __forceinline__ float fast_sigmoid(float v) { return __builtin_amdgcn_rcpf(1.0f + __builtin_amdgcn_exp2f(-v * LOG2E)); }
__device__ __forceinline__ unsigned pack_gate4(f32x4 g) { unsigned w = 0u; w = __builtin_amdgcn_cvt_pk_u8_f32(g[0] * 256.0f - 0.5f, 0, w); w = __builtin_amdgcn_cvt_pk_u8_f32(g[1] * 256.0f - 0.5f, 1, w);
    w = __builtin_amdgcn_cvt_pk_u8_f32(g[2] * 256.0f - 0.5f, 2, w); w = __builtin_amdgcn_cvt_pk_u8_f32(g[3] * 256.0f - 0.5f, 3, w); return w; }
__device__ __forceinline__ f32x4 unpack_gate4(unsigned w) { const f32x4 q = {(float)(w & 0xffu), (float)((w >> 8) & 0xffu), (float)((w >> 16) & 0xffu), (float)(w >> 24)};
    return q * (1.0f / 256.0f) + (0.5f / 256.0f); }
__device__ __forceinline__ u32x4 pack8(f32x4 a, f32x4 b) { u32x4 w; w.x = cvt_pk_bf16(a[0], a[1]); w.y = cvt_pk_bf16(a[2], a[3]); w.z = cvt_pk_bf16(b[0], b[1]); w.w = cvt_pk_bf16(b[2], b[3]); return w; }
__device__ __forceinline__ u32x4 pack8_w7(f32x4 a, f32x4 b) { u32x4 w; w.x = cvt_pk_w7(a[0], a[1]); w.y = cvt_pk_w7(a[2], a[3]); w.z = cvt_pk_w7(b[0], b[1]); w.w = cvt_pk_w7(b[2], b[3]); return w; }
__device__ __forceinline__ void unpack8(u32x4 w, f32x4& a, f32x4& b) { a = (f32x4){bf_lo(w.x), bf_hi(w.x), bf_lo(w.y), bf_hi(w.y)}; b = (f32x4){bf_lo(w.z), bf_hi(w.z), bf_lo(w.w), bf_hi(w.w)}; }

namespace pg8 {
constexpr int BM = 256, BK = 64, HALF = 128, HTB = HALF * BK * 2, STAGE_BYTES = 8 * HTB, NXCD = 8, WGM = 4;
__host__ __device__ __forceinline__ int lds_byte(int r, int c) { const int st = (r >> 4) * 2 + (c >> 5), rr = r & 15, cc = c & 31, ob = rr * 64 + cc * 2; return st * 1024 + (ob ^ (((ob >> 9) & 1) << 5)); }
__host__ __device__ __forceinline__ void stage_rc(int b, int& R, int& C) { const int st = b / 1024, sb = b % 1024, swz = sb ^ (((sb >> 9) & 1) << 5); R = (st >> 1) * 16 + swz / 64; C = (st & 1) * 32 + (swz % 64) / 2; }
__host__ __device__ __forceinline__ int perm32(int rho) { const int n = rho >> 4, i = rho & 15; return 8 * (i >> 2) + 4 * n + (i & 3); }

constexpr int BJ = 32;
struct Unit { int pm, pn, k0, nt, tag; };
struct Gemm { const bf16* A; const bf16* Bt; int lda, ldb; int apair; };

__device__ __forceinline__ void tile_of(int wgid, int nM, int nN, int& pm, int& pn) {
    const int nwg = nM * nN;
    { const int q = nwg / NXCD, r = nwg % NXCD, xcd = wgid % NXCD, off = wgid / NXCD; wgid = (xcd < r ? xcd * (q + 1) : r * (q + 1) + (xcd - r) * q) + off; }
    const int nig = WGM * nN, gid = wgid / nig, fm = gid * WGM, gsz = (nM - fm) < WGM ? (nM - fm) : WGM;
    pm = fm + ((wgid % nig) % gsz); pn = (wgid % nig) / gsz;
}
struct StaticOrder {
    int nM, nN, nwg, G, c, nt;
    __device__ __forceinline__ void init(int Mr, int Nc, int K, int G_, int c_) { nM = Mr / BM; nN = Nc / BM; nwg = nM * nN; G = G_; c = c_; nt = K / BK; }
    __device__ __forceinline__ bool next(int i, Unit& u) const {
        const long L = (long)i * G + c; if (L >= nwg) return false;
        tile_of((int)L, nM, nN, u.pm, u.pn); u.k0 = 0; u.nt = nt; u.tag = 0; return true; }
};
struct MergeOrder {
    int nM, nN, nwg, G, c;
    __device__ __forceinline__ void init(int Mr, int Nc, int G_, int c_) { nM = Mr / BM; nN = Nc / BM; nwg = nM * nN; G = G_; c = c_; }
    __device__ __forceinline__ bool next(int i, Unit& u) const {
        const int ti = i / 3, j = i - 3 * ti; const long L = (long)ti * G + c; if (L >= nwg) return false;
        tile_of((int)L, nM, nN, u.pm, u.pn); u.tag = j; u.k0 = (j == 0) ? 0 : (j == 1 ? 1024 : 1536); u.nt = (j == 0) ? 16 : 8; return true; }
};
struct S5Order1 {
    int G, c;
    __device__ __forceinline__ bool next(int i, Unit& u) const {
        const int L = i * G + c; if (L >= 128) return false;
        u.pm = L; u.pn = L >> 2; u.k0 = 0; u.nt = 8; u.tag = 0; return true; }
};
struct S5Order2L {
    int G, c;
    __device__ __forceinline__ bool next(int i, Unit& u) const {
        const int L = (i >> 1) * G + c; if (L >= 128) return false;
        u.pm = L; u.pn = (L >> 2) * 2 + (i & 1); u.k0 = 0; u.nt = 10; u.tag = 0; return true; }
};
struct S5Order2 {
    int G, c;
    __device__ __forceinline__ bool next(int i, Unit& u) const {
        const int L = i * G + c; if (L >= 256) return false;
        const int g = L >> 3, r = L & 7; u.pm = g * 4 + (r >> 1); u.pn = g * 2 + (r & 1); u.k0 = 0; u.nt = 10; u.tag = 0; return true; }
};

template <class Epi, class Sched>
__device__ __forceinline__ void gemm_phase(LAS unsigned char* lds, const Gemm g, const Sched& S, const Epi& E) {
    int tid = threadIdx.x; asm volatile("" : "+v"(tid));
    const int wid = __builtin_amdgcn_readfirstlane(tid >> 6), lane = tid & 63, wr = wid >> 2, wc = wid & 3, fr = lane & 15, fq = lane >> 4;
    unsigned voffA[2], voffB[2];
#pragma unroll
    for (int i = 0; i < 2; ++i) { int R, C; stage_rc(tid * 16 + i * 8192, R, C); const int Rb = Epi::PERM ? (64 * (R >> 5) + perm32(R & 31)) : R;
        voffA[i] = g.apair ? (unsigned)((R >> 1) * 2 * g.lda + (C >> 5) * 64 + (R & 1) * 32 + (C & 31)) * 2u : (unsigned)(R * g.lda + C) * 2u; voffB[i] = (unsigned)(Rb * g.ldb + C) * 2u; }
    const size_t kstep = (size_t)(BK * 2), kstepA = g.apair ? 2 * kstep : kstep;
    const size_t hA = (size_t)HALF * g.lda * 2, hB = (size_t)(Epi::PERM ? BJ : HALF) * g.ldb * 2;
    const size_t tA = 2 * hA, tB = (size_t)BM * g.ldb * 2;
    const unsigned ldsw = (unsigned)wid * 1024u;
    const int aoff = lds_byte(wr * 64 + fr, fq * 8), boff = lds_byte(wc * 32 + fr, fq * 8);
#define PG8_SA(b, h) (((b) * 2 + (h)) * HTB)
#define PG8_SB(b, h) ((4 + (b) * 2 + (h)) * HTB)
#define PG8_STAGE(bufoff, gbase, voff) do { _Pragma("unroll") for (int _i = 0; _i < 2; ++_i) \
        __builtin_amdgcn_global_load_lds((const unsigned*)((const char*)(gbase) + (voff)[_i]), (LAS unsigned*)(lds + (bufoff) + ldsw + _i * 8192), 16, 0, 0); } while (0)
#define PG8_LDA(dst, b, h) do { _Pragma("unroll") for (int m = 0; m < 4; ++m) _Pragma("unroll") for (int k = 0; k < 2; ++k) dst[m][k] = *(const LAS bf16x8*)(lds + PG8_SA(b, h) + aoff + m * 2048 + k * 1024); } while (0)
#define PG8_LDB(dst, b, h) do { _Pragma("unroll") for (int n = 0; n < 2; ++n) _Pragma("unroll") for (int k = 0; k < 2; ++k) dst[n][k] = *(const LAS bf16x8*)(lds + PG8_SB(b, h) + boff + n * 2048 + k * 1024); } while (0)
#define PG8_MMA(ai, bj, At, Bt) do { __builtin_amdgcn_s_setprio(1); _Pragma("unroll") for (int m = 0; m < 4; ++m) _Pragma("unroll") for (int n = 0; n < 2; ++n) _Pragma("unroll") for (int k = 0; k < 2; ++k) \
        acc[ai][bj][m][n] = __builtin_amdgcn_mfma_f32_16x16x32_bf16(Bt[n][k], At[m][k], acc[ai][bj][m][n], 0, 0, 0); __builtin_amdgcn_s_setprio(0); } while (0)
#define PG8_WAIT_V(n) asm volatile("s_waitcnt vmcnt(" #n ")" ::: "memory")
#define PG8_WAIT_L(n) asm volatile("s_waitcnt lgkmcnt(" #n ")" ::: "memory")
#define PG8_BAR __builtin_amdgcn_s_barrier()
#define PG8_SCHED __builtin_amdgcn_sched_barrier(0)
    Unit cur, nxt; int ui = 0;
    if (!S.next(0, cur)) return;
    f32x4 acc[2][2][4][2];
#pragma unroll
    for (int a = 0; a < 2; ++a)
#pragma unroll
        for (int b = 0; b < 2; ++b)
#pragma unroll
            for (int m = 0; m < 4; ++m)
#pragma unroll
                for (int n = 0; n < 2; ++n) acc[a][b][m][n] = (f32x4){0.f, 0.f, 0.f, 0.f};
    bf16x8 At[4][2], B0[2][2], B1[2][2];
    const char* cA = (const char*)g.A + (size_t)cur.pm * tA + (size_t)cur.k0 * 2; const char* cB = (const char*)g.Bt + (size_t)cur.pn * tB + (size_t)cur.k0 * 2;
    PG8_STAGE(PG8_SB(0, 0), cB, voffB); PG8_STAGE(PG8_SB(0, 1), cB + hB, voffB); PG8_STAGE(PG8_SA(0, 0), cA, voffA); PG8_STAGE(PG8_SA(0, 1), cA + hA, voffA);
    if (wr == 1) PG8_BAR;
    PG8_WAIT_V(2); PG8_BAR;
    PG8_STAGE(PG8_SB(1, 0), cB + kstep, voffB); PG8_STAGE(PG8_SA(1, 0), cA + kstepA, voffA); PG8_STAGE(PG8_SB(1, 1), cB + hB + kstep, voffB);
    PG8_WAIT_V(6); PG8_BAR;
    for (;;) {
        const bool has_next = S.next(ui + 1, nxt);
        const char* nA = has_next ? (const char*)g.A + (size_t)nxt.pm * tA + (size_t)nxt.k0 * 2 : cA; const char* nB = has_next ? (const char*)g.Bt + (size_t)nxt.pn * tB + (size_t)nxt.k0 * 2 : cB;
        const int nt = cur.nt;
        for (int t = 0; t < nt; t += 2) {
            const bool last = (t == nt - 2);
            const char* a1 = cA + (size_t)(t + 1) * kstepA;
            const char* a2 = last ? nA : cA + (size_t)(t + 2) * kstepA; const char* b2 = last ? nB : cB + (size_t)(t + 2) * kstep;
            const char* a3 = a2 + kstepA; const char* b3 = b2 + kstep;
            PG8_LDB(B0, 0, 0); PG8_LDB(B1, 0, 1); PG8_SCHED; PG8_LDA(At, 0, 0); PG8_STAGE(PG8_SA(1, 1), a1 + hA, voffA);
            PG8_WAIT_V(8); PG8_WAIT_L(0); PG8_BAR; PG8_MMA(0, 0, At, B0); PG8_MMA(0, 1, At, B1); PG8_BAR; PG8_SCHED;
            PG8_LDA(At, 0, 1); PG8_STAGE(PG8_SB(0, 0), b2, voffB); PG8_STAGE(PG8_SB(0, 1), b2 + hB, voffB); PG8_STAGE(PG8_SA(0, 0), a2, voffA);
            PG8_WAIT_V(8); PG8_WAIT_L(0); PG8_BAR; PG8_MMA(1, 0, At, B0); PG8_MMA(1, 1, At, B1); PG8_BAR; PG8_SCHED;
            PG8_LDB(B0, 1, 0); PG8_LDB(B1, 1, 1); PG8_SCHED; PG8_LDA(At, 1, 0); PG8_STAGE(PG8_SA(0, 1), a2 + hA, voffA);
            PG8_WAIT_V(8); PG8_WAIT_L(0); PG8_BAR; PG8_MMA(0, 0, At, B0); PG8_MMA(0, 1, At, B1); PG8_BAR; PG8_SCHED;
            PG8_LDA(At, 1, 1); PG8_STAGE(PG8_SB(1, 0), b3, voffB); PG8_STAGE(PG8_SB(1, 1), b3 + hB, voffB); PG8_STAGE(PG8_SA(1, 0), a3, voffA);
            PG8_WAIT_V(8); PG8_WAIT_L(0); PG8_BAR; PG8_MMA(1, 0, At, B0); PG8_MMA(1, 1, At, B1); PG8_BAR; PG8_SCHED;
        }
        if (wr == 0) PG8_BAR;
        E(acc, cur, wr, wc, fr, fq);
        if (!has_next) break;
        if (!E.keep(cur)) {
            bf16x8 zf = {0, 0, 0, 0, 0, 0, 0, 0}; asm volatile("" : "+v"(zf));
#pragma unroll
            for (int a = 0; a < 2; ++a)
#pragma unroll
                for (int b = 0; b < 2; ++b)
#pragma unroll
                    for (int m = 0; m < 4; ++m)
#pragma unroll
                        for (int n = 0; n < 2; ++n) acc[a][b][m][n] = __builtin_amdgcn_mfma_f32_16x16x32_bf16(zf, zf, (f32x4){0.f, 0.f, 0.f, 0.f}, 0, 0, 0);
        }
        cur = nxt; cA = nA; cB = nB; ++ui;
        if (wr == 1) PG8_BAR;
    }
    PG8_WAIT_V(0);
    PG8_BAR;
#undef PG8_SA
#undef PG8_SB
#undef PG8_STAGE
#undef PG8_LDA
#undef PG8_LDB
#undef PG8_MMA
#undef PG8_WAIT_V
#undef PG8_WAIT_L
#undef PG8_BAR
#undef PG8_SCHED
}

typedef f32x4 Acc[2][2][4][2];
struct EpiInProj {
    static constexpr bool PERM = true;
    const float* bias; bf16* qkv; bf16* a2; bf16* qm; unsigned char* gates;
    __device__ __forceinline__ bool keep(const Unit&) const { return false; }
    __device__ __forceinline__ void operator()(Acc& acc, const Unit& u, int wr, int wc, int fr, int fq) const {
        const int rowb = u.pm * BM + wr * 64 + fr, colb = u.pn * BM + wc * 64 + 8 * fq;
        bf16* base; int sA, sM2, sM1; bool sig = false;
        if (u.pn < 12) { base = qkv + (size_t)rowb * 3072 + colb; sA = 128 * 3072; sM2 = 32 * 3072; sM1 = 16 * 3072; }
        else if (u.pn < 14) { const int ch = colb - 3072, gg = ch >> 4, c = ch & 15;
            base = a2 + ((size_t)(gg * ROWS_G + u.pm * 8 + wr * 2) * K2 + fr * 16 + c); sA = 4 * K2; sM2 = K2; sM1 = 256; }
        else if (u.pn < 16) { base = qm + (size_t)rowb * 512 + (colb - 3584); sA = 128 * 512; sM2 = 32 * 512; sM1 = 16 * 512; }
        else { base = (bf16*)(gates + (size_t)rowb * 6144 + (colb - 4096)); sA = 64 * 6144; sM2 = 16 * 6144; sM1 = 8 * 6144; sig = true; }
        const int sB = (u.pn >= 12 && u.pn < 14) ? 2 * ROWS_G * K2 : (u.pn >= 16 ? BJ / 2 : BJ);
        f32x4 bv[2][2];
#pragma unroll
        for (int bj = 0; bj < 2; ++bj)
#pragma unroll
            for (int n = 0; n < 2; ++n) bv[bj][n] = *(const f32x4*)(bias + colb + bj * BJ + 4 * n);
#pragma unroll
        for (int ai = 0; ai < 2; ++ai)
#pragma unroll
            for (int m = 0; m < 4; ++m) { bf16* rowp = base + (size_t)ai * sA + (size_t)(m >> 1) * sM2 + (size_t)(m & 1) * sM1;
#pragma unroll
                for (int bj = 0; bj < 2; ++bj) { f32x4 v0 = acc[ai][bj][m][0] + bv[bj][0], v1 = acc[ai][bj][m][1] + bv[bj][1];
                    if (sig) {
#pragma unroll
                        for (int e = 0; e < 4; ++e) { v0[e] = fast_sigmoid(v0[e]); v1[e] = fast_sigmoid(v1[e]); }
                        *(u32x2*)(rowp + (size_t)bj * sB) = (u32x2){pack_gate4(v0), pack_gate4(v1)}; }
                    else *(u32x4*)(rowp + (size_t)bj * sB) = pack8(v0, v1); } }
    }
};
struct EpiStoreBf16 {
    static constexpr bool PERM = true;
    bf16* O; int ldc;
    __device__ __forceinline__ bool keep(const Unit&) const { return false; }
    __device__ __forceinline__ void operator()(Acc& acc, const Unit& u, int wr, int wc, int fr, int fq) const {
        const int row0 = u.pm * BM + wr * 64 + fr, colb = u.pn * BM + wc * 64 + 8 * fq;
#pragma unroll
        for (int ai = 0; ai < 2; ++ai)
#pragma unroll
            for (int m = 0; m < 4; ++m)
#pragma unroll
                for (int bj = 0; bj < 2; ++bj) *(u32x4*)(O + (size_t)(row0 + ai * HALF + m * 16) * ldc + colb + bj * BJ) = pack8(acc[ai][bj][m][0], acc[ai][bj][m][1]);
    }
};
template <int MODE> struct EpiGated {
    static constexpr bool PERM = true;
    bf16* O; int ldc;
    __device__ __forceinline__ bool keep(const Unit&) const { return false; }
    __device__ __forceinline__ void operator()(Acc& acc, const Unit& u, int wr, int wc, int fr, int fq) const {
        const int row0 = u.pm * BM + wr * 64 + fr, col = u.pn * HALF + wc * 32 + 8 * fq;
#pragma unroll
        for (int ai = 0; ai < 2; ++ai)
#pragma unroll
            for (int m = 0; m < 4; ++m) { f32x4 o[2];
#pragma unroll
                for (int n = 0; n < 2; ++n)
#pragma unroll
                    for (int e = 0; e < 4; ++e) { const float a = acc[ai][0][m][n][e], b = acc[ai][1][m][n][e]; o[n][e] = (MODE == 0) ? a * fast_sigmoid(a) * b : a * fast_sigmoid(b); }
                const int r = row0 + ai * HALF + m * 16;
                bf16* dst = (MODE == 0) ? O + (size_t)(r >> 1) * 2 * ldc + (size_t)(col >> 5) * 64 + (r & 1) * 32 + (col & 31) : O + (size_t)r * ldc + col;
                *(u32x4*)dst = pack8(o[0], o[1]); }
    }
};
struct EpiMerge {
    static constexpr bool PERM = true;
    const unsigned char* gates; bf16* O;
    __device__ __forceinline__ bool keep(const Unit& u) const { return u.tag < 2; }
    __device__ __forceinline__ void operator()(Acc& acc, const Unit& u, int wr, int wc, int fr, int fq) const {
        const int row0 = u.pm * BM + wr * 64 + fr, colb = u.pn * BM + wc * 64 + 8 * fq, j = u.tag;
#pragma unroll
        for (int ai = 0; ai < 2; ++ai)
#pragma unroll
            for (int m = 0; m < 4; ++m) { const int row = row0 + ai * HALF + m * 16;
#pragma unroll
                for (int bj = 0; bj < 2; ++bj) { const int col = colb + bj * BJ; const unsigned char* gp = gates + (size_t)row * 6144 + j * 2048 + col;
                    const u32x2 gw = *(const u32x2*)gp; const f32x4 g0 = unpack_gate4(gw.x), g1 = unpack_gate4(gw.y);
                    if (j < 2) { const u32x2 hw = *(const u32x2*)(gp + 2048); const f32x4 h0 = unpack_gate4(hw.x), h1 = unpack_gate4(hw.y);
#pragma unroll
                        for (int e = 0; e < 4; ++e) { acc[ai][bj][m][0][e] *= g0[e] * __builtin_amdgcn_rcpf(fmaxf(h0[e], 1e-30f)); acc[ai][bj][m][1][e] *= g1[e] * __builtin_amdgcn_rcpf(fmaxf(h1[e], 1e-30f)); } }
                    else *(u32x4*)(O + (size_t)row * 2048 + col) = pack8(acc[ai][bj][m][0] * g0, acc[ai][bj][m][1] * g1); } }
    }
};
__device__ __forceinline__ void store_pair128(_Float16* p, size_t row8, u32x4 d0, u32x4 d1, bool lo) {
    u32x4 s0, s1;
#pragma unroll
    for (int i = 0; i < 4; ++i) { const unsigned snd = lo ? d1[i] : d0[i]; const unsigned rcv = (unsigned)__builtin_amdgcn_mov_dpp((int)snd, 0x128, 0xf, 0xf, true); s0[i] = lo ? d0[i] : rcv; s1[i] = lo ? rcv : d1[i]; }
    *(u32x4*)p = s0; *(u32x4*)(p + row8) = s1;
}
struct EpiRes {
    static constexpr bool PERM = true;
    const float* x; _Float16* pre; const f32x2* st; const float* gam; const float* bet;
    __device__ __forceinline__ bool keep(const Unit&) const { return false; }
    __device__ __forceinline__ void operator()(Acc& acc, const Unit& u, int wr, int wc, int fr, int fq) const {
        const int row0 = u.pm * BM + wr * 64 + fr, colb = u.pn * BM + wc * 64 + 8 * fq;
        const bool lo = fr < 8; const size_t sbase = (size_t)(row0 - fr + (fr & 7)) * DM + colb + (lo ? 0 : BJ);
        f32x4 gv[2][2], bv[2][2];
        if (!x) {
#pragma unroll
            for (int bj = 0; bj < 2; ++bj)
#pragma unroll
                for (int n = 0; n < 2; ++n) { gv[bj][n] = *(const f32x4*)(gam + colb + bj * BJ + 4 * n) * DN_ALPHA; bv[bj][n] = *(const f32x4*)(bet + colb + bj * BJ + 4 * n) * DN_ALPHA; }
        }
        if (x) {
#pragma unroll
            for (int ai = 0; ai < 2; ++ai)
#pragma unroll
                for (int m = 0; m < 4; ++m) { const size_t ro = (size_t)(row0 + ai * HALF + m * 16) * DM + colb; u32x4 dd[2];
#pragma unroll
                    for (int bj = 0; bj < 2; ++bj) { const f32x4 r0 = *(const f32x4*)(x + ro + bj * BJ), r1 = *(const f32x4*)(x + ro + bj * BJ + 4);
                        const f32x4 o0 = r0 * DN_ALPHA + acc[ai][bj][m][0], o1 = r1 * DN_ALPHA + acc[ai][bj][m][1];
                        const f32x8 o = {o0[0], o0[1], o0[2], o0[3], o1[0], o1[1], o1[2], o1[3]};
                        dd[bj] = __builtin_bit_cast(u32x4, __builtin_convertvector(o, h16x8)); }
                    store_pair128(pre + sbase + (size_t)(ai * HALF + m * 16) * DM, (size_t)8 * DM, dd[0], dd[1], lo);
                    if (m & 1) asm volatile("" ::: "memory"); }
        } else {
#pragma unroll
            for (int ai = 0; ai < 2; ++ai)
#pragma unroll
              for (int mp = 0; mp < 4; mp += 2) {
                f32x2 ms[2]; h16x8 rr[2][2];
#pragma unroll
                for (int m = 0; m < 2; ++m) { const int row = row0 + ai * HALF + (mp + m) * 16; ms[m] = st[row];
#pragma unroll
                    for (int bj = 0; bj < 2; ++bj) rr[m][bj] = *(const h16x8*)(pre + (size_t)row * DM + colb + bj * BJ); }
                asm volatile("" ::: "memory");
#pragma unroll
                for (int m = 0; m < 2; ++m) { u32x4 dd[2];
#pragma unroll
                    for (int bj = 0; bj < 2; ++bj) { const f32x8 r = __builtin_convertvector(rr[m][bj], f32x8);
                        const f32x4 r0 = {r[0], r[1], r[2], r[3]}, r1 = {r[4], r[5], r[6], r[7]};
                        const f32x4 o0 = ((r0 - ms[m].x) * ms[m].y) * gv[bj][0] + bv[bj][0] + acc[ai][bj][mp + m][0], o1 = ((r1 - ms[m].x) * ms[m].y) * gv[bj][1] + bv[bj][1] + acc[ai][bj][mp + m][1];
                        const f32x8 o = {o0[0], o0[1], o0[2], o0[3], o1[0], o1[1], o1[2], o1[3]};
                        dd[bj] = __builtin_bit_cast(u32x4, __builtin_convertvector(o, h16x8)); }
                    store_pair128(pre + sbase + (size_t)(ai * HALF + (mp + m) * 16) * DM, (size_t)8 * DM, dd[0], dd[1], lo); }
                asm volatile("" ::: "memory"); }
        }
    }
};
struct EpiS1 {
    static constexpr bool PERM = false;
    float* S;
    __device__ __forceinline__ bool keep(const Unit&) const { return false; }
    __device__ __forceinline__ void operator()(Acc& acc, const Unit& u, int wr, int wc, int fr, int fq) const {
        const int row0 = u.pm * BM + wr * 64 + fr, colb = wc * 32 + 4 * fq;
#pragma unroll
        for (int ai = 0; ai < 2; ++ai)
#pragma unroll
            for (int m = 0; m < 4; ++m)
#pragma unroll
                for (int n = 0; n < 2; ++n) *(f32x4*)(S + (size_t)(row0 + ai * HALF + m * 16) * 128 + colb + n * 16) = acc[ai][0][m][n];
    }
};
struct EpiS2 {
    static constexpr bool PERM = true;
    const bf16* a2; const float* dskip; bf16* gbuf;
    __device__ __forceinline__ bool keep(const Unit&) const { return false; }
    __device__ __forceinline__ void operator()(Acc& acc, const Unit& u, int wr, int wc, int fr, int fq) const {
        const int R0 = u.pm * BM + wr * 64 + fr, gg = u.pm >> 2, nb = (u.pn & 1) * BM + wc * 64 + 8 * fq;
#pragma unroll
        for (int bj = 0; bj < 2; ++bj) { const int np = nb + bj * BJ, i = np >> 4, c0 = np & 15;
            const f32x4 d0 = *(const f32x4*)(dskip + gg * 16 + c0), d1 = *(const f32x4*)(dskip + gg * 16 + c0 + 4);
#pragma unroll
            for (int ai = 0; ai < 2; ++ai)
#pragma unroll
                for (int m = 0; m < 4; ++m) { const int R = R0 + ai * HALF + m * 16; const int token = (R & (ROWS_G - 1)) * TCH + i;
                    f32x4 u0, u1; unpack8(*(const u32x4*)(a2 + (size_t)R * K2 + i * 16 + c0), u0, u1);
                    f32x4 y0 = acc[ai][bj][m][0] + d0 * u0, y1 = acc[ai][bj][m][1] + d1 * u1;
#pragma unroll
                    for (int e = 0; e < 4; ++e) { { const float y = y0[e]; const float t = 1.5957691216057308f * y * (1.0f + 0.044715f * y * y); y0[e] = y * fast_sigmoid(t); }
                                                  { const float y = y1[e]; const float t = 1.5957691216057308f * y * (1.0f + 0.044715f * y * y); y1[e] = y * fast_sigmoid(t); } }
                    *(u32x4*)(gbuf + (size_t)token * 512 + gg * 16 + c0) = pack8(y0, y1); } }
    }
};
}

namespace att {
constexpr int QBLK = 32, KVBLK = 64;
constexpr int SHM_T = 16384;
#define KSWZ(row, colB) ((row) * 256 + ((colB) ^ (((row) & 7) << 4)))
#define SBAR() __builtin_amdgcn_sched_barrier(0)
__device__ __forceinline__ int crow(int r, int hi) { return (r & 3) + 8 * (r >> 2) + 4 * hi; }
__device__ __forceinline__ void qkt(f32x16& p0, f32x16& p1, const LAS char* Ks, const bf16x8* qr, int r32, int hi) {
    p0 = f32x16{}; p1 = f32x16{};
    bf16x8 kf[16];
#pragma unroll
    for (int d0 = 0; d0 < 8; ++d0) { const int cb = (d0 * 16 + hi * 8) * 2;
        kf[2 * d0] = *(const LAS bf16x8*)(Ks + KSWZ(r32, cb)); kf[2 * d0 + 1] = *(const LAS bf16x8*)(Ks + KSWZ(32 + r32, cb)); }
    SBAR();
#pragma unroll
    for (int d0 = 0; d0 < 8; ++d0) {
        p0 = __builtin_amdgcn_mfma_f32_32x32x16_bf16(kf[2 * d0], qr[d0], p0, 0, 0, 0);
        p1 = __builtin_amdgcn_mfma_f32_32x32x16_bf16(kf[2 * d0 + 1], qr[d0], p1, 0, 0, 0); }
}
__device__ __forceinline__ int v_st(int k, int c) { const int kk = (k & ~0xC) | ((k & 4) << 1) | ((k & 8) >> 1); return ((kk >> 3) * 4 + (c >> 5)) * 512 + ((kk & 7) * 32 + (c & 31)) * 2; }
__device__ __forceinline__ int v_rd_base(int lane) { return ((lane & 3) << 3) | (((lane >> 2) & 3) << 6) | (((lane >> 4) & 1) << 5) | (((lane >> 5) & 1) << 8); }
constexpr int v_rd_off(int d0, int ks, int half) { return d0 * 512 + ks * 4096 + half * 2048; }
template <int OFF> __device__ __forceinline__ s16x4 tr_read(int vb) { s16x4 r; asm volatile("ds_read_b64_tr_b16 %0, %1 offset:%2" : "=&v"(r) : "v"(vb), "i"(OFF) : "memory"); return r; }
template <int D0> __device__ __forceinline__ void pv_one(f32x16& od, int vb, bf16x8 pa0, bf16x8 pa1, bf16x8 pa2, bf16x8 pa3) {
    const s16x4 l0 = tr_read<v_rd_off(D0, 0, 0)>(vb), h0 = tr_read<v_rd_off(D0, 0, 1)>(vb), l1 = tr_read<v_rd_off(D0, 1, 0)>(vb), h1 = tr_read<v_rd_off(D0, 1, 1)>(vb);
    const s16x4 l2 = tr_read<v_rd_off(D0, 2, 0)>(vb), h2 = tr_read<v_rd_off(D0, 2, 1)>(vb), l3 = tr_read<v_rd_off(D0, 3, 0)>(vb), h3 = tr_read<v_rd_off(D0, 3, 1)>(vb);
    asm volatile("s_waitcnt lgkmcnt(0)" ::: "memory"); SBAR();
#define PK(L, H) (bf16x8){L[0], L[1], L[2], L[3], H[0], H[1], H[2], H[3]}
    od = __builtin_amdgcn_mfma_f32_32x32x16_bf16(pa0, PK(l0, h0), od, 0, 0, 0);
    od = __builtin_amdgcn_mfma_f32_32x32x16_bf16(pa1, PK(l1, h1), od, 0, 0, 0);
    od = __builtin_amdgcn_mfma_f32_32x32x16_bf16(pa2, PK(l2, h2), od, 0, 0, 0);
    od = __builtin_amdgcn_mfma_f32_32x32x16_bf16(pa3, PK(l3, h3), od, 0, 0, 0);
#undef PK
}
__device__ __forceinline__ void pv_d0(f32x16* o, int vb, bf16x8 pa0, bf16x8 pa1, bf16x8 pa2, bf16x8 pa3) {
    pv_one<0>(o[0], vb, pa0, pa1, pa2, pa3); pv_one<1>(o[1], vb, pa0, pa1, pa2, pa3); pv_one<2>(o[2], vb, pa0, pa1, pa2, pa3); pv_one<3>(o[3], vb, pa0, pa1, pa2, pa3);
}
#define PK4(P, BASE, OUT) do { unsigned a0 = cvt_pk_bf16(P[BASE + 0], P[BASE + 1]), a1 = cvt_pk_bf16(P[BASE + 2], P[BASE + 3]);   \
    unsigned b0 = cvt_pk_bf16(P[BASE + 4], P[BASE + 5]), b1 = cvt_pk_bf16(P[BASE + 6], P[BASE + 7]);                              \
    auto r0 = __builtin_amdgcn_permlane32_swap(a0, b0, false, false); auto r1 = __builtin_amdgcn_permlane32_swap(a1, b1, false, false); \
    u32x4 w = {r0[0], r1[0], r0[1], r1[1]}; OUT = __builtin_bit_cast(bf16x8, w); } while (0)

__device__ __forceinline__ void sb_weights(f32x16& p0, f32x16& p1, float& carry, int jb, int qrel, int hi) {
    f32x16 M0, M1;
#pragma unroll
    for (int r = 0; r < 16; ++r) {
        { const float z = __builtin_amdgcn_fmed3f(p0[r] * ATT_C, -60.f, 60.f); const float t = __builtin_amdgcn_exp2f(-z); const float b = __builtin_amdgcn_rcpf(1.0f + t); p0[r] = b; M0[r] = t * b; }
        { const float z = __builtin_amdgcn_fmed3f(p1[r] * ATT_C, -60.f, 60.f); const float t = __builtin_amdgcn_exp2f(-z); const float b = __builtin_amdgcn_rcpf(1.0f + t); p1[r] = b; M1[r] = t * b; }
    }
    if (jb >= 0) {
        const int kb = 64 * jb + 4 * hi;
#pragma unroll
        for (int r = 0; r < 16; ++r) { const int kv = kb + (r & 3) + 8 * (r >> 2);
            if (kv >= qrel) { M0[r] = 1.f; p0[r] = 0.f; }
            if (kv + 32 >= qrel) { M1[r] = 1.f; p1[r] = 0.f; } }
    }
    float glo[8], ghi[8];
#pragma unroll
    for (int g = 0; g < 4; ++g) {
        const float s0 = (M0[4 * g] * M0[4 * g + 1]) * (M0[4 * g + 2] * M0[4 * g + 3]);
        const float s1 = (M1[4 * g] * M1[4 * g + 1]) * (M1[4 * g + 2] * M1[4 * g + 3]);
        auto r0 = __builtin_amdgcn_permlane32_swap(__float_as_uint(s0), __float_as_uint(s0), false, false);
        auto r1 = __builtin_amdgcn_permlane32_swap(__float_as_uint(s1), __float_as_uint(s1), false, false);
        glo[g] = __uint_as_float(r0[0]); ghi[g] = __uint_as_float(r0[1]); glo[4 + g] = __uint_as_float(r1[0]); ghi[4 + g] = __uint_as_float(r1[1]);
    }
    float run = carry;
#pragma unroll
    for (int gi = 7; gi >= 0; --gi) {
        const float base_hi = run; run *= ghi[gi]; const float base_lo = run; run *= glo[gi];
        float a = hi ? base_hi : base_lo;
        if (gi >= 4) { const int g = gi - 4;
            const float w3 = p1[4 * g + 3] * a; a *= M1[4 * g + 3];
            const float w2 = p1[4 * g + 2] * a; a *= M1[4 * g + 2];
            const float w1 = p1[4 * g + 1] * a; a *= M1[4 * g + 1];
            const float w0 = p1[4 * g + 0] * a;
            p1[4 * g + 3] = w3; p1[4 * g + 2] = w2; p1[4 * g + 1] = w1; p1[4 * g + 0] = w0;
        } else { const int g = gi;
            const float w3 = p0[4 * g + 3] * a; a *= M0[4 * g + 3];
            const float w2 = p0[4 * g + 2] * a; a *= M0[4 * g + 2];
            const float w1 = p0[4 * g + 1] * a; a *= M0[4 * g + 1];
            const float w0 = p0[4 * g + 0] * a;
            p0[4 * g + 3] = w3; p0[4 * g + 2] = w2; p0[4 * g + 1] = w1; p0[4 * g + 0] = w0;
        }
    }
    carry = (run < 1.17549435e-38f) ? 0.f : run;
}

struct Stg { bf16x8 v0, v1, k0, k1; };
#define ATT_SLOAD(st, key0) do { st.v0 = *(const bf16x8*)(Vh + (size_t)((key0) + sr) * LDK + sc); st.v1 = *(const bf16x8*)(Vh + (size_t)((key0) + 32 + sr) * LDK + sc); \
    st.k0 = *(const bf16x8*)(Kh + (size_t)((key0) + sr) * LDK + sc); st.k1 = *(const bf16x8*)(Kh + (size_t)((key0) + 32 + sr) * LDK + sc); } while (0)
#define ATT_SWRITE(vbuf, kbuf, st) do { *(LAS bf16x8*)((vbuf) + vst0) = st.v0; *(LAS bf16x8*)((vbuf) + vst1) = st.v1; \
    *(LAS bf16x8*)((kbuf) + KSWZ(sr, sc * 2)) = st.k0; *(LAS bf16x8*)((kbuf) + KSWZ(32 + sr, sc * 2)) = st.k1; } while (0)

template <int LDQ, int LDK, int LDO>
__device__ __forceinline__ void sb_unit(const bf16* __restrict__ Qb, const bf16* __restrict__ Kh, const bf16* __restrict__ Vh, bf16* __restrict__ Ob, int qb, LAS char* lds, LAS unsigned* flg) {
    int tid = threadIdx.x; asm volatile("" : "+v"(tid));
    const int wid = __builtin_amdgcn_readfirstlane(tid >> 6), lane = tid & 63, r32 = lane & 31, hi = lane >> 5;
    LAS char* V_lds = lds; LAS char* K_lds = lds + 2 * SHM_T;
    f32x16 o[4] = {}; bf16x8 qr[8];
    const bf16* Qw = Qb + (size_t)(wid * QBLK + r32) * LDQ + hi * 8;
#pragma unroll
    for (int d0 = 0; d0 < 8; ++d0) qr[d0] = *(const bf16x8*)(Qw + d0 * 16);
    const int sr = tid >> 4, sc = (tid & 15) * 8, vst0 = v_st(sr, sc), vst1 = v_st(32 + sr, sc);
    const int vb0 = (int)(uintptr_t)V_lds + v_rd_base(lane);
    const int NT = 4 * (qb + 1), qrel = wid * QBLK + r32;
    Stg st;
    ATT_SLOAD(st, (NT - 1) * KVBLK); ATT_SWRITE(V_lds, K_lds, st);
    if (NT > 1) ATT_SLOAD(st, (NT - 2) * KVBLK);
    __syncthreads();
    float carry = 1.f; bool wdone = false;
    for (int t = 0; t < NT; ++t) {
        const int buf = t & 1, jt = NT - 1 - t, jb = jt - 4 * qb;
        const bool active = (jb < 0) || (jb * 64 < wid * QBLK + 31);
        if (active && !wdone) {
            f32x16 p0, p1; bf16x8 pa0, pa1, pa2, pa3;
            qkt(p0, p1, K_lds + buf * SHM_T, qr, r32, hi);
            sb_weights(p0, p1, carry, jb, qrel, hi);
            PK4(p0, 0, pa0); PK4(p0, 8, pa1); PK4(p1, 0, pa2); PK4(p1, 8, pa3);
            SBAR();
            pv_d0(o, vb0 + buf * SHM_T, pa0, pa1, pa2, pa3);
        }
        wdone = __all(carry == 0.0f); if (lane == 0) flg[(t & 1) * 8 + wid] = wdone ? 1u : 0u;
        if (t + 1 < NT) ATT_SWRITE(V_lds + (buf ^ 1) * SHM_T, K_lds + (buf ^ 1) * SHM_T, st);
        if (t + 2 < NT) ATT_SLOAD(st, (NT - 3 - t) * KVBLK);
        __syncthreads();
        { const LAS u32x4* f4 = (const LAS u32x4*)(flg + (t & 1) * 8); const u32x4 fa = f4[0], fb = f4[1];
          if ((fa.x & fa.y & fa.z & fa.w & fb.x & fb.y & fb.z & fb.w) != 0u) break; }
    }
    bf16* Ow = Ob + (size_t)(wid * QBLK) * LDO;
#pragma unroll
    for (int r = 0; r < 16; ++r) { const int orow = crow(r, hi);
#pragma unroll
        for (int d0 = 0; d0 < 4; ++d0) Ow[(size_t)orow * LDO + d0 * 32 + r32] = (bf16)(cvt_pk_bf16(o[d0][r], 0.f) & 0xffffu); }
}

template <int LDQ, int LDK, int LDO>
__device__ __forceinline__ void mem_unit(const bf16* __restrict__ Qb0, const bf16* __restrict__ Kh, const bf16* __restrict__ Vh, bf16* __restrict__ Ob0, int nq, LAS char* lds, LAS float* ws) {
    int tid = threadIdx.x; asm volatile("" : "+v"(tid));
    const int wid = __builtin_amdgcn_readfirstlane(tid >> 6), lane = tid & 63, r32 = lane & 31, hi = lane >> 5;
    LAS char* V_lds = lds; LAS char* K_lds = lds + 4 * SHM_T;
    const int sr = tid >> 4, sc = (tid & 15) * 8, vst0 = v_st(sr, sc), vst1 = v_st(32 + sr, sc);
    const int vb0 = (int)(uintptr_t)V_lds + v_rd_base(lane);
#pragma unroll
    for (int t = 0; t < 4; ++t) { Stg st; ATT_SLOAD(st, t * KVBLK); ATT_SWRITE(V_lds + t * SHM_T, K_lds + t * SHM_T, st); }
    __syncthreads();
#pragma unroll 1
    for (int qi = 0; qi < nq; ++qi) {
    const bf16* Qb = Qb0 + (size_t)qi * 256 * LDQ; bf16* Ob = Ob0 + (size_t)qi * 256 * LDO;
    f32x16 o[4] = {}; bf16x8 qr[8];
    const bf16* Qw = Qb + (size_t)(wid * QBLK + r32) * LDQ + hi * 8;
#pragma unroll
    for (int d0 = 0; d0 < 8; ++d0) qr[d0] = *(const bf16x8*)(Qw + d0 * 16);
    float mx = -INFINITY;
#pragma unroll 1
    for (int t = 0; t < 4; ++t) { f32x16 p0, p1; qkt(p0, p1, K_lds + t * SHM_T, qr, r32, hi);
#pragma unroll
        for (int r = 0; r < 16; ++r) mx = fmaxf(mx, fmaxf(p0[r], p1[r])); }
    { auto rr = __builtin_amdgcn_permlane32_swap(__float_as_uint(mx), __float_as_uint(mx), false, false); mx = fmaxf(__uint_as_float(rr[0]), __uint_as_float(rr[1])); }
    const float mC = -mx * ATT_C; float l = 0.f;
#pragma unroll 1
    for (int t = 0; t < 4; ++t) { f32x16 p0, p1; bf16x8 pa0, pa1, pa2, pa3; qkt(p0, p1, K_lds + t * SHM_T, qr, r32, hi);
#pragma unroll
        for (int r = 0; r < 16; ++r) { p0[r] = __builtin_amdgcn_exp2f(fmaf(p0[r], ATT_C, mC)); p1[r] = __builtin_amdgcn_exp2f(fmaf(p1[r], ATT_C, mC)); l += p0[r] + p1[r]; }
        PK4(p0, 0, pa0); PK4(p0, 8, pa1); PK4(p1, 0, pa2); PK4(p1, 8, pa3);
        SBAR();
        pv_d0(o, vb0 + t * SHM_T, pa0, pa1, pa2, pa3); }
    { auto rr = __builtin_amdgcn_permlane32_swap(__float_as_uint(l), __float_as_uint(l), false, false); l = __uint_as_float(rr[0]) + __uint_as_float(rr[1]); }
    if (hi == 0) ws[r32] = l;
    asm volatile("s_waitcnt lgkmcnt(0)" ::: "memory");
    bf16* Ow = Ob + (size_t)(wid * QBLK) * LDO;
#pragma unroll
    for (int r = 0; r < 16; ++r) { const int orow = crow(r, hi); const float rl = __builtin_amdgcn_rcpf(ws[orow]);
#pragma unroll
        for (int d0 = 0; d0 < 4; ++d0) Ow[(size_t)orow * LDO + d0 * 32 + r32] = (bf16)(cvt_pk_bf16(o[d0][r] * rl, 0.f) & 0xffffu); }
    }
    __syncthreads();
}
#undef ATT_SLOAD
#undef ATT_SWRITE
#undef PK4
#undef SBAR
#undef KSWZ
}

#define XB_TMO      128
#define XB_XCNT(j)  (256  + 64 * (j))
#define XB_XSUB(j)  (1280 + 64 * (j))
#define XB_XGEN(j)  (2304 + 64 * (j))
#define XB_TOP      3328
#define XB_TOPGEN   3392
#define XCD_BAR_WORDS 3456
#define XB_SPIN_CAP (1u << 18)
__device__ __forceinline__ unsigned xb_ld(unsigned* p)              { return __hip_atomic_load(p, __ATOMIC_RELAXED, __HIP_MEMORY_SCOPE_AGENT); }
__device__ __forceinline__ unsigned xb_add(unsigned* p, unsigned v) { return __hip_atomic_fetch_add(p, v, __ATOMIC_RELAXED, __HIP_MEMORY_SCOPE_AGENT); }
__device__ __forceinline__ unsigned xb_xcc_id() { return (unsigned)__builtin_amdgcn_s_getreg((3 << 11) | 20) & 0xFu; }
#define XB_SPIN(cond, bar) do { unsigned _sp = 0; while (cond) { __builtin_amdgcn_s_sleep(1); \
    if ((++_sp & 255u) == 0u) { if (xb_ld(&(bar)[XB_TMO])) break; if (_sp > XB_SPIN_CAP) { atomicAdd(&(bar)[XB_TMO], 1u); break; } } } } while (0)
struct XcdBarrier { unsigned* bar; unsigned x; volatile LAS unsigned* st; unsigned members; };
__device__ __forceinline__ XcdBarrier xcd_barrier_post(unsigned* bar, volatile LAS unsigned* st, unsigned members) {
    XcdBarrier b; b.bar = bar; b.x = xb_xcc_id(); b.st = st; b.members = members;
    if (threadIdx.x == 0) (void)xb_add(&bar[XB_XCNT(b.x)], 1u);
    return b;
}
__device__ __forceinline__ void xcd_barrier_complete(unsigned* bar, unsigned x, unsigned& nloc, unsigned& nx, unsigned G) {
    unsigned sum, cnt, mine, sp = 0u;
    for (;;) {
        sum = 0u; cnt = 0u; mine = 0u;
#pragma unroll
        for (unsigned j = 0; j < 16; ++j) { const unsigned c = xb_ld(&bar[XB_XCNT(j)]); sum += c; cnt += (c > 0u) ? 1u : 0u; mine = (j == x) ? c : mine; }
        if (sum == G) break;
        __builtin_amdgcn_s_sleep(1);
        if ((++sp & 255u) == 0u) { if (xb_ld(&bar[XB_TMO])) break; if (sp > XB_SPIN_CAP) { atomicAdd(&bar[XB_TMO], 1u); break; } }
    }
    nloc = mine > 0u ? mine : 1u; nx = cnt > 0u ? cnt : 1u;
}
__device__ __forceinline__ void xcd_barrier(const XcdBarrier& b) {
    asm volatile("s_waitcnt vmcnt(0)" ::: "memory");
    __syncthreads();
    if (threadIdx.x == 0) {
        unsigned* bar = b.bar;
        __builtin_amdgcn_s_waitcnt(0);
        unsigned nloc = b.st[0], nx = b.st[1];
        if (nloc == 0u) { xcd_barrier_complete(bar, b.x, nloc, nx, b.members); b.st[0] = nloc; b.st[1] = nx; }
        const unsigned old = xb_add(&bar[XB_XSUB(b.x)], 1u);
        const unsigned gen = old / nloc;
        if (old + 1u == (gen + 1u) * nloc) {
            __builtin_amdgcn_fence(__ATOMIC_RELEASE, "agent");
            asm volatile("s_waitcnt vmcnt(0)" ::: "memory");
            const unsigned og = xb_add(&bar[XB_TOP], 1u);
            const unsigned tg = og / nx;
            if (og + 1u == (tg + 1u) * nx) xb_add(&bar[XB_TOPGEN], 1u);
            else XB_SPIN(xb_ld(&bar[XB_TOPGEN]) == tg, bar);
            __builtin_amdgcn_fence(__ATOMIC_ACQUIRE, "agent");
            xb_add(&bar[XB_XGEN(b.x)], 1u);
            asm volatile("s_waitcnt vmcnt(0)" ::: "memory");
        } else {
            XB_SPIN(xb_ld(&bar[XB_XGEN(b.x)]) == gen, bar);
            __builtin_amdgcn_fence(__ATOMIC_ACQUIRE, "agent");
            asm volatile("s_waitcnt vmcnt(0)" ::: "memory");
        }
    }
    __syncthreads();
}

__device__ __forceinline__ float wave_sum(float v) {
#pragma unroll
    for (int o = 1; o < 64; o <<= 1) v += __shfl_xor(v, o);
    return v;
}
__device__ __forceinline__ int gated_row(int n, int H) { const int second = n >= H, f = second ? n - H : n; return (f >> 7) * 256 + ((f >> 5) & 3) * 64 + second * 32 + (f & 31); }
__device__ __forceinline__ void transpose_item(const float* __restrict__ W, int N, bf16* __restrict__ WT, int ld, int koff, int HG, LAS float* scr, int item, int lane) {
    const int nblk = N / 32, kb = item / nblk, nb = item % nblk, k0 = 64 * kb, n0 = 32 * nb;
    { f32x4 v[8]; const int kr = lane >> 3, n4 = (lane & 7) * 4;
#pragma unroll
      for (int i = 0; i < 8; ++i) v[i] = *(const f32x4*)(W + (size_t)(k0 + kr + 8 * i) * N + n0 + n4);
#pragma unroll
      for (int i = 0; i < 8; ++i) { LAS float* d = scr + (kr + 8 * i) * 33 + n4; d[0] = v[i][0]; d[1] = v[i][1]; d[2] = v[i][2]; d[3] = v[i][3]; } }
    asm volatile("s_waitcnt lgkmcnt(0)" ::: "memory");
    const int c = lane & 7;
#pragma unroll
    for (int j = 0; j < 4; ++j) { const int n = (lane >> 3) + 8 * j; const LAS float* s = scr + (8 * c) * 33 + n;
        u32x4 o; o.x = cvt_pk_w7(s[0 * 33], s[1 * 33]); o.y = cvt_pk_w7(s[2 * 33], s[3 * 33]); o.z = cvt_pk_w7(s[4 * 33], s[5 * 33]); o.w = cvt_pk_w7(s[6 * 33], s[7 * 33]);
        const int drow = HG ? gated_row(n0 + n, HG) : (n0 + n);
        *(u32x4*)(WT + (size_t)drow * ld + koff + k0 + 8 * c) = o; }
    asm volatile("s_waitcnt lgkmcnt(0)" ::: "memory");
}

struct Args { const float* in[24]; float* out; unsigned char* ws; int ph_lo, ph_hi; };

constexpr int NWAVES = 8;
constexpr int PH_PER_LAYER = 12, N_PHASES = 2 + PH_PER_LAYER * DEPTH;

__global__ void __launch_bounds__(NWAVES * 64, 2) hybrid_fwd(Args args) {
    extern __shared__ __attribute__((aligned(16))) unsigned char lds_raw[];
    LAS unsigned char* lds = (LAS unsigned char*)lds_raw;
    volatile LAS unsigned* MISC = (volatile LAS unsigned*)(lds + MISC_OFF);
    const int tid = threadIdx.x, wave = __builtin_amdgcn_readfirstlane(tid >> 6);
    const int G = gridDim.x, bx = blockIdx.x;
    const int vcu = (G % 8 == 0) ? (bx % 8) * (G / 8) + bx / 8 : bx;
    const int gw = vcu * NWAVES + wave, NGW = G * NWAVES;
    const int NGT = G * NWAVES * 64;
#define FRESH_IDS() int tid_ = threadIdx.x; asm volatile("" : "+v"(tid_)); const int lane = tid_ & 63; const int gt = bx * (NWAVES * 64) + tid_; (void)lane; (void)gt
    unsigned char* ws = args.ws;
    unsigned* ctl = (unsigned*)(ws + WS_CTL);
    for (int u = tid; u < 128; u += NWAVES * 64) ((LAS unsigned*)(lds + MISC_OFF))[u] = 0u;
    __syncthreads();
    XcdBarrier bar = xcd_barrier_post(ctl + CW_BAR, MISC + 8, (unsigned)G);
    const bool use_grp = (G % 8 == 0) && ((M / 8) % (NGW / 8) == 0);
    XcdBarrier gbar = bar; if (use_grp) gbar = xcd_barrier_post(ctl + CW_GBAR + (bx % 8) * 4096, MISC + 12, (unsigned)(G / 8));
    const int lo = args.ph_lo, hi = args.ph_hi;
#ifndef PH_EN
#define PH_EN 0xFFFFu
#endif
#define IN(k) (lo <= (k) && (k) < hi)
#define INL(j) (((PH_EN >> (j)) & 1u) && IN(P + (j)))
#define INP(j) (((PH_EN >> (12 + (j))) & 1u) && IN(j))
#define SEAM(k) do { if (IN(k) && IN((k) + 1)) xcd_barrier(bar); } while (0)
#define GSEAM(k) do { if (IN(k) && IN((k) + 1)) xcd_barrier(gbar); } while (0)

    bf16* BT_IN = (bf16*)(ws + WS_BT_IN); bf16* BT_CAT = (bf16*)(ws + WS_BT_CAT); bf16* BT_GLU = (bf16*)(ws + WS_BT_GLU); bf16* BT_KV = (bf16*)(ws + WS_BT_KV);
    bf16* BT_O = (bf16*)(ws + WS_BT_O); bf16* BT_GU = (bf16*)(ws + WS_BT_GU); bf16* BT_DN = (bf16*)(ws + WS_BT_DN); bf16* BT_S1 = (bf16*)(ws + WS_BT_S1); bf16* BT_S2 = (bf16*)(ws + WS_BT_S2);
    float* KC = (float*)(ws + WS_KC); f32x2* LP = (f32x2*)(ws + WS_LP); f32x2* CF = (f32x2*)(ws + WS_CF); f32x2* STAT = (f32x2*)(ws + WS_STAT);
    bf16* XB = (bf16*)(ws + WS_XB); bf16* QKV = (bf16*)(ws + WS_QKV); unsigned char* GATES = (unsigned char*)(ws + WS_GATES); bf16* HID = (bf16*)(ws + WS_HID); bf16* QM = (bf16*)(ws + WS_QM);
    bf16* A2 = (bf16*)(ws + WS_A2); float* SS = (float*)(ws + WS_S); bf16* KVM = (bf16*)(ws + WS_KVM); bf16* MEMB = (bf16*)(ws + WS_MEMB); bf16* ACAT = (bf16*)(ws + WS_ACAT);
    bf16* GBUF = (bf16*)(ws + WS_GBUF); bf16* MERGED = (bf16*)(ws + WS_MERGED); bf16* BT_KV4 = (bf16*)(ws + WS_BT_KV4); bf16* KVM4 = (bf16*)(ws + WS_KVM4); _Float16* PRE = (_Float16*)(ws + WS_PRE);
    float* OUT = args.out;

    if (INP(0)) { FRESH_IDS();
        for (int idx = gt; idx < DEPTH * NG * NP; idx += NGT) {
            const int lg = idx >> 6, p = idx & 63;
            const float lre = args.in[5][idx], lim = args.in[6][idx], dt = expf(args.in[7][lg]);
            const float a = lre * dt, b = lim * dt;
            for (int tau = 0; tau <= TCH; ++tau) { const float mg = expf(a * (float)tau); float sn, cs; sincosf(b * (float)tau, &sn, &cs); LP[(size_t)(lg * 33 + tau) * 64 + p] = (f32x2){mg * cs, mg * sn}; }
            float sn, cs, sh, ch; sincosf(b, &sn, &cs); sincosf(0.5f * b, &sh, &ch); (void)ch;
            const float nr = expm1f(a) * cs - 2.0f * sh * sh, ni = expf(a) * sn;
            const float den = 1.0f / (lre * lre + lim * lim);
            CF[idx] = (f32x2){(nr * lre + ni * lim) * den, (ni * lre - nr * lim) * den};
        }
    }
    if (INP(0)) { FRESH_IDS();
        LAS float* scr = (LAS float*)(lds + wave * 16384);
        constexpr int I_KV1 = (DM / 64) * (1024 / 32);
        for (int it = gw; it < DEPTH * I_KV1; it += NGW) { const int ll = it / I_KV1, r = it - ll * I_KV1;
            transpose_item(args.in[15] + (size_t)ll * DM * 1024, 1024, BT_KV4 + (size_t)ll * 1024 * DM, DM, 0, 0, scr, r, lane); }
        const float* mem = args.in[1];
        for (size_t ch = gt; ch < (size_t)BATCH * MEMT * DM / 8; ch += NGT) { const f32x4 a = *(const f32x4*)(mem + ch * 8), b = *(const f32x4*)(mem + ch * 8 + 4); *(u32x4*)(MEMB + ch * 8) = pack8(a, b); }
    }
    SEAM(0);
    if (INP(1)) { FRESH_IDS();
        for (int idx = gt; idx < DEPTH * NG * TCH * 256; idx += NGT) {
            const int cp = idx & 15, c = (idx >> 4) & 15, tau = (idx >> 8) & 31, lg = idx >> 13;
            const float* cre = args.in[10] + (size_t)(lg * 16 + c) * 64; const float* cim = args.in[11] + (size_t)(lg * 16 + c) * 64;
            const float* bre = args.in[8] + (size_t)lg * 64 * 16 + cp; const float* bim = args.in[9] + (size_t)lg * 64 * 16 + cp;
            const f32x2* lp = LP + (size_t)(lg * 33 + tau) * 64; const f32x2* cf = CF + (size_t)lg * 64;
            float s = 0.f;
            for (int p = 0; p < 64; ++p) {
                const f32x2 w = lp[p], f = cf[p]; const float wr_ = w.x * f.x - w.y * f.y, wi_ = w.x * f.y + w.y * f.x;
                const float br = bre[p * 16], bi = bim[p * 16]; const float xr = wr_ * br - wi_ * bi, xi = wr_ * bi + wi_ * br;
                s += cre[p] * xr - cim[p] * xi;
            }
            KC[idx] = s;
        }
    }
    if (INP(1)) {
        pg8::Gemm g{MEMB, BT_KV4, DM, DM}; pg8::StaticOrder S; S.init(BATCH * MEMT, DEPTH * 1024, DM, G, bx);
        pg8::EpiStoreBf16 E{KVM4, DEPTH * 1024};
        pg8::gemm_phase(lds, g, S, E);
    }
    SEAM(1);

#define LN_PHASE(gam, bet, FINAL) do { \
            f32x4 gv[4][2], bv[4][2]; \
            _Pragma("unroll") for (int j = 0; j < 4; ++j) _Pragma("unroll") for (int n = 0; n < 2; ++n) { gv[j][n] = *((const f32x4*)(gam) + (lane + 64 * j) * 2 + n); bv[j][n] = *((const f32x4*)(bet) + (lane + 64 * j) * 2 + n); } \
              \
            const bool xl_ = (G % 8 == 0) && ((M / 8) % (NGW / 8) == 0); const int cnt_ = xl_ ? (M / 8) / (NGW / 8) : (M - gw + NGW - 1) / NGW; \
            for (int i_ = 0; i_ < cnt_; ++i_) { const int m = xl_ ? (vcu / (G / 8)) * (M / 8) + (cnt_ - 1 - i_) * (NGW / 8) + (gw % (NGW / 8)) : gw + i_ * NGW; \
                const h16x8* xr = (const h16x8*)(PRE + (size_t)m * DM) + lane; f32x8 v[4]; float s = 0.f; \
                _Pragma("unroll") for (int j = 0; j < 4; ++j) { v[j] = __builtin_convertvector(xr[64 * j], f32x8); s += ((v[j][0] + v[j][1]) + (v[j][2] + v[j][3])) + ((v[j][4] + v[j][5]) + (v[j][6] + v[j][7])); } \
                const float mean = wave_sum(s) * (1.f / DM); float s2 = 0.f; \
                _Pragma("unroll") for (int j = 0; j < 4; ++j) { v[j] = v[j] - mean; const f32x8 q = v[j] * v[j]; s2 += ((q[0] + q[1]) + (q[2] + q[3])) + ((q[4] + q[5]) + (q[6] + q[7])); } \
                const float rstd = 1.f / sqrtf(wave_sum(s2) * (1.f / DM) + LN_EPS); \
                if (FINAL) { f32x4* o4 = (f32x4*)(OUT + (size_t)m * DM) + lane * 2; \
                    _Pragma("unroll") for (int j = 0; j < 4; ++j) { const f32x4 a = {v[j][0], v[j][1], v[j][2], v[j][3]}, b = {v[j][4], v[j][5], v[j][6], v[j][7]}; \
                        o4[128 * j] = a * rstd * gv[j][0] + bv[j][0]; o4[128 * j + 1] = b * rstd * gv[j][1] + bv[j][1]; } } \
                else { if (lane == 0) STAT[m] = (f32x2){mean, rstd}; \
                    u32x4* o8 = (u32x4*)(XB + (size_t)m * DM) + lane; \
                    _Pragma("unroll") for (int j = 0; j < 4; ++j) { const f32x4 a = {v[j][0], v[j][1], v[j][2], v[j][3]}, b = {v[j][4], v[j][5], v[j][6], v[j][7]}; \
                        o8[64 * j] = pack8_w7(a * rstd * gv[j][0] + bv[j][0], b * rstd * gv[j][1] + bv[j][1]); } } \
            } } while (0)
#define CUR(p) ((bf16*)((unsigned char*)(p) + dcur))
#define NXT(p) ((bf16*)((unsigned char*)(p) + dnxt))
#pragma unroll 1
    for (int l = -1; l < DEPTH; ++l) {
        const int P = (l >= 0) ? 2 + PH_PER_LAYER * l : -1000, lq = (l >= 0) ? l : 0, lc = l + 1;
        const size_t dcur = (lq & 1) ? WS_ALT_DELTA : 0, dnxt = (lc & 1) ? WS_ALT_DELTA : 0;
        const float* b_in = args.in[3] + (size_t)lq * INW;
        if (INL(0) && l > 0) { FRESH_IDS(); LN_PHASE(args.in[22] + (size_t)(l - 1) * DM, args.in[23] + (size_t)(l - 1) * DM, false); }
        SEAM(P + 0);
        if (INL(1)) {
            { pg8::Gemm g{XB, CUR(BT_IN), DM, DM}; pg8::StaticOrder S; S.init(M, INW, DM, G, bx);
              pg8::EpiInProj E{b_in, QKV, A2, QM, GATES};
              pg8::gemm_phase(lds, g, S, E); }
        }
        if (IN(P + 1) && IN(P + 4)) xcd_barrier(bar);
        { const bool conv_on = (lc < DEPTH) && ((PH_EN >> 0) & 1u) && (l < 0 ? IN(2) : IN(P + 4)), mix_on = INL(4);
          int par = (l >= 0) ? (vcu & 1) : 0; par = __builtin_amdgcn_readfirstlane(par); asm volatile("" : "+s"(par));
#pragma unroll 1
          for (int pass = 0; pass < 2; ++pass) {
            if (pass == par) { if (conv_on) { FRESH_IDS();
            const float* w_inc = args.in[2] + (size_t)lc * DM * INW;
            LAS float* scr = (LAS float*)(lds + wave * 16384);
            constexpr int I_IN = (DM / 64) * (INW / 32), I_SB = (SBW / 64) * (DM / 32), I_SS = (SSMW / 64) * (DM / 32), I_MM = (MEMW / 64) * (DM / 32), I_GL = (SSMW / 64) * (1024 / 32),
                          I_O = (DM / 64) * (DM / 32), I_GU = (DM / 64) * (2 * DFF / 32), I_DN = (DFF / 64) * (DM / 32);
            constexpr int NITEMS = I_IN + I_SB + I_SS + I_MM + I_GL + I_O + I_GU + I_DN;
            for (int it = gw; it < NITEMS; it += NGW) {
                int r = it; const float* W; bf16* WT; int N, ld, koff = 0, HG = 0;
                if (r < I_IN) { W = w_inc; N = INW; WT = NXT(BT_IN); ld = DM; }
                else if ((r -= I_IN) < I_SB) { W = args.in[4] + (size_t)lc * SBW * DM; N = DM; WT = NXT(BT_CAT); ld = DM; }
                else if ((r -= I_SB) < I_SS) { W = args.in[14] + (size_t)lc * SSMW * DM; N = DM; WT = NXT(BT_CAT); ld = DM; koff = 1024; }
                else if ((r -= I_SS) < I_MM) { W = args.in[16] + (size_t)lc * MEMW * DM; N = DM; WT = NXT(BT_CAT); ld = DM; koff = 1536; }
                else if ((r -= I_MM) < I_GL) { W = args.in[13] + (size_t)lc * SSMW * 1024; N = 1024; WT = NXT(BT_GLU); ld = SSMW; HG = 512; }
                else if ((r -= I_GL) < I_O) { W = args.in[17] + (size_t)lc * DM * DM; N = DM; WT = NXT(BT_O); ld = DM; }
                else if ((r -= I_O) < I_GU) { W = args.in[20] + (size_t)lc * DM * 2 * DFF; N = 2 * DFF; WT = NXT(BT_GU); ld = DM; HG = DFF; }
                else { r -= I_GU; W = args.in[21] + (size_t)lc * DFF * DM; N = DM; WT = NXT(BT_DN); ld = DFF; }
                transpose_item(W, N, WT, ld, koff, HG, scr, r, lane);
            }
            for (int ch = gt; ch < NG * 512 * 80; ch += NGT) {
                const int kc = ch % 80, n = (ch / 80) & 511, g = ch / (80 * 512), i = n >> 4, c = n & 15, lg = lc * NG + g, kk0 = kc * 8;
                f32x4 v0 = {0.f, 0.f, 0.f, 0.f}, v1 = v0;
                if (kk0 < 512) { const int s = kk0 >> 4, cp0 = kk0 & 15;
                    if (s <= i) { const float* src = KC + ((size_t)(lg * 32 + (i - s)) * 16 + c) * 16 + cp0; v0 = *(const f32x4*)src; v1 = *(const f32x4*)(src + 4); } }
                else { const int p0 = (kk0 - 512) & 63; const bool im = (kk0 - 512) >= 64;
                    const float* cre = args.in[10] + (size_t)(lg * 16 + c) * 64 + p0; const float* cim = args.in[11] + (size_t)(lg * 16 + c) * 64 + p0; const f32x2* lp = LP + (size_t)(lg * 33 + i + 1) * 64 + p0;
#pragma unroll
                    for (int e = 0; e < 8; ++e) { const f32x2 w = lp[e]; const float val = im ? -(cre[e] * w.y + cim[e] * w.x) : (cre[e] * w.x - cim[e] * w.y); if (e < 4) v0[e] = val; else v1[e - 4] = val; } }
                *(u32x4*)(NXT(BT_S2) + ((size_t)(g * 512 + n) * K2 + kk0)) = pack8(v0, v1);
            }
            for (int ch = gt; ch < NG * 256 * 64; ch += NGT) {
                const int kc = ch & 63, j = (ch >> 6) & 255, g = ch >> 14, lg = lc * NG + g, kk0 = kc * 8, s = kk0 >> 4, cp0 = kk0 & 15;
                f32x4 v0 = {0.f, 0.f, 0.f, 0.f}, v1 = v0;
                if (j < 128) { const int p = j & 63; const bool im = j >= 64;
                    const f32x2 w = LP[(size_t)(lg * 33 + (TCH - 1 - s)) * 64 + p], f = CF[(size_t)lg * 64 + p]; const float wr_ = w.x * f.x - w.y * f.y, wi_ = w.x * f.y + w.y * f.x;
                    const float* bre = args.in[8] + ((size_t)lg * 64 + p) * 16 + cp0; const float* bim = args.in[9] + ((size_t)lg * 64 + p) * 16 + cp0;
#pragma unroll
                    for (int e = 0; e < 8; ++e) { const float val = im ? (wr_ * bim[e] + wi_ * bre[e]) : (wr_ * bre[e] - wi_ * bim[e]); if (e < 4) v0[e] = val; else v1[e - 4] = val; } }
                *(u32x4*)(NXT(BT_S1) + ((size_t)(g * 256 + j) * 512 + kk0)) = pack8(v0, v1);
            }
            if (lc == 0) {
                const float* x = args.in[0];
                size_t ch = gt;
                for (; ch + (size_t)3 * NGT < (size_t)M * DM / 8; ch += (size_t)4 * NGT) {
                    f32x4 a[4], b[4];
#pragma unroll
                    for (int q = 0; q < 4; ++q) { a[q] = *(const f32x4*)(x + (ch + (size_t)q * NGT) * 8); b[q] = *(const f32x4*)(x + (ch + (size_t)q * NGT) * 8 + 4); }
#pragma unroll
                    for (int q = 0; q < 4; ++q) *(u32x4*)(XB + (ch + (size_t)q * NGT) * 8) = pack8(a[q], b[q]); }
                for (; ch < (size_t)M * DM / 8; ch += NGT) { const f32x4 a = *(const f32x4*)(x + ch * 8), b = *(const f32x4*)(x + ch * 8 + 4); *(u32x4*)(XB + ch * 8) = pack8(a, b); }
            }
            __syncthreads(); } }
            else if (mix_on) {
            if (vcu < 128) {
                { pg8::Gemm g{A2, CUR(BT_S1), K2, 512}; pg8::S5Order1 S{G, vcu}; pg8::EpiS1 E{SS};
                  pg8::gemm_phase(lds, g, S, E); }
                asm volatile("s_waitcnt vmcnt(0)" ::: "memory"); __syncthreads();
                { FRESH_IDS();
                  if (wave < 2) for (int L = vcu; L < 128; L += G) {
                    const int g = L >> 2, b = (L & 3) * 2 + wave, lg = l * NG + g, p = lane;
                    const f32x2 a = LP[(size_t)(lg * 33 + TCH) * 64 + p];
                    float hr = 0.f, hi_ = 0.f;
                    const size_t R0 = (size_t)g * ROWS_G + b * NCH;
                    const float* sp = SS + R0 * 128 + p; bf16* dp = A2 + R0 * K2 + 512 + p;
#pragma unroll 1
                    for (int k0 = 0; k0 < NCH; k0 += 32) {
                        float sr_[32], si_[32];
#pragma unroll
                        for (int i = 0; i < 32; ++i) { sr_[i] = sp[(size_t)(k0 + i) * 128]; si_[i] = sp[(size_t)(k0 + i) * 128 + 64]; }
                        asm volatile("" ::: "memory");
#pragma unroll
                        for (int i = 0; i < 32; ++i) {
                            bf16* dst = dp + (size_t)(k0 + i) * K2;
                            dst[0] = (bf16)(cvt_pk_bf16(hr, 0.f) & 0xffffu); dst[64] = (bf16)(cvt_pk_bf16(hi_, 0.f) & 0xffffu);
                            const float nr = a.x * hr - a.y * hi_ + sr_[i], ni = a.x * hi_ + a.y * hr + si_[i];
                            hr = nr; hi_ = ni;
                        }
                    }
                  } }
                asm volatile("s_waitcnt vmcnt(0)" ::: "memory"); __syncthreads();
                { pg8::Gemm g{A2, CUR(BT_S2), K2, K2}; pg8::S5Order2L S{G, vcu}; pg8::EpiS2 E{A2, args.in[12] + (size_t)l * SSMW, GBUF};
                  pg8::gemm_phase(lds, g, S, E); }
            }
            for (int o = vcu; o < 256; o += G) {
                const int s0 = (o < 128) ? 2 * o : 256 + 6 * (o - 128), ns = (o < 128) ? 2 : 6;
                for (int j = 0; j < ns; ++j) {
                    const int su = s0 + j, bh = su >> 4, qb = su & 15, b = bh >> 3, h = bh & 7;
                    const size_t row0 = (size_t)b * SEQ;
                    att::sb_unit<3072, 3072, 2048>(QKV + (row0 + qb * 256) * 3072 + h * 128, QKV + row0 * 3072 + 1024 + h * 128, QKV + row0 * 3072 + 2048 + h * 128,
                                                    ACAT + (row0 + qb * 256) * 2048 + h * 128, qb, (LAS char*)lds, (LAS unsigned*)(lds + ATTFLG_OFF));
                }
            }
            for (int u = vcu; u < 256; u += G) {
                const int b = u >> 5, h = (u >> 3) & 3, qb = (u & 7) * 2;
                const size_t row0 = (size_t)b * SEQ + qb * 256;
                att::mem_unit<512, DEPTH * 1024, 2048>(QM + row0 * 512 + h * 128, KVM4 + (size_t)b * MEMT * DEPTH * 1024 + l * 1024 + h * 128, KVM4 + (size_t)b * MEMT * DEPTH * 1024 + l * 1024 + 512 + h * 128,
                                                ACAT + row0 * 2048 + 1536 + h * 128, 2, (LAS char*)lds, (LAS float*)(lds + ATTWS_OFF) + wave * 64);
            }
            __syncthreads(); }
          } }
        SEAM(P + 4);
        if (INL(5)) {
            pg8::Gemm g{GBUF, CUR(BT_GLU), SSMW, SSMW}; pg8::StaticOrder S; S.init(M, 1024, SSMW, G, bx); pg8::EpiGated<1> E{ACAT + 1024, 2048};
            pg8::gemm_phase(lds, g, S, E);
        }
        GSEAM(P + 5);
        if (INL(6)) {
            pg8::Gemm g{ACAT, CUR(BT_CAT), DM, DM}; pg8::MergeOrder S; S.init(M, DM, G, bx); pg8::EpiMerge E{GATES, MERGED};
            pg8::gemm_phase(lds, g, S, E);
        }
        GSEAM(P + 6);
        if (INL(7)) {
            pg8::Gemm g{MERGED, CUR(BT_O), DM, DM}; pg8::StaticOrder S; S.init(M, DM, DM, G, bx); pg8::EpiRes E{l == 0 ? args.in[0] : nullptr, PRE, STAT, args.in[22] + (size_t)(l > 0 ? l - 1 : 0) * DM, args.in[23] + (size_t)(l > 0 ? l - 1 : 0) * DM};
            pg8::gemm_phase(lds, g, S, E);
        }
        GSEAM(P + 7);
        if (INL(8)) { FRESH_IDS(); LN_PHASE(args.in[18] + (size_t)l * DM, args.in[19] + (size_t)l * DM, false); }
        SEAM(P + 8);
        if (INL(9)) {
            pg8::Gemm g{XB, CUR(BT_GU), DM, DM}; pg8::StaticOrder S; S.init(M, 2 * DFF, DM, G, bx); pg8::EpiGated<0> E{HID, DFF};
            pg8::gemm_phase(lds, g, S, E);
        }
        GSEAM(P + 9);
        if (INL(10)) {
            pg8::Gemm g{HID, CUR(BT_DN), DFF, DFF, 1}; pg8::StaticOrder S; S.init(M, DM, DFF, G, bx); pg8::EpiRes E{nullptr, PRE, STAT, args.in[18] + (size_t)l * DM, args.in[19] + (size_t)l * DM};
            pg8::gemm_phase(lds, g, S, E);
        }
        if (l == DEPTH - 1) { GSEAM(P + 10); if (INL(11)) { FRESH_IDS(); LN_PHASE(args.in[22] + (size_t)l * DM, args.in[23] + (size_t)l * DM, true); } }
        else if (IN(P + 10) && IN(P + 12)) xcd_barrier(gbar);
    }
#undef IN
#undef SEAM
}

#ifndef MK_SPLIT
#define MK_SPLIT 0
#endif
extern "C" void kernel_launch(void* const* d_in, const int* in_sizes, int n_in, void* d_out, int out_size, void* d_ws, size_t ws_size, hipStream_t stream) {
    static int grid = 0;
    if (grid == 0) {
        if (n_in != 24 || in_sizes[0] != M * DM || out_size != M * DM || ws_size < WS_END) { fprintf(stderr, "kernel_launch: shape mismatch (n_in %d, in0 %d, out %d, ws %zu, need %zu)\n", n_in, n_in > 0 ? in_sizes[0] : -1, out_size, ws_size, (size_t)WS_END); grid = -1; return; }
        int dev = 0, cus = 0, per_cu = 0;
        if (hipGetDevice(&dev) != hipSuccess || hipDeviceGetAttribute(&cus, hipDeviceAttributeMultiprocessorCount, dev) != hipSuccess) { grid = -1; return; }
        if (hipFuncSetAttribute((const void*)hybrid_fwd, hipFuncAttributeMaxDynamicSharedMemorySize, LDS_BYTES) != hipSuccess) { fprintf(stderr, "kernel_launch: hipFuncSetAttribute failed\n"); grid = -1; return; }
        if (hipOccupancyMaxActiveBlocksPerMultiprocessor(&per_cu, (const void*)hybrid_fwd, NWAVES * 64, LDS_BYTES) != hipSuccess || per_cu < 1) { fprintf(stderr, "kernel_launch: occupancy query reports %d\n", per_cu); }
        (void)hipGetLastError();
        grid = cus;
    }
    if (grid < 0) return;
    if (hipMemsetAsync((char*)d_ws + WS_CTL, 0, CTL_ZERO_BYTES, stream) != hipSuccess) return;
    Args a{};
    for (int i = 0; i < 24; ++i) a.in[i] = (const float*)d_in[i];
    a.out = (float*)d_out; a.ws = (unsigned char*)d_ws;
#if MK_SPLIT
    for (int p = 0; p < N_PHASES; ++p) { a.ph_lo = p; a.ph_hi = p + 1; hipLaunchKernelGGL(hybrid_fwd, dim3(grid), dim3(NWAVES * 64), LDS_BYTES, stream, a); }
#else
    a.ph_lo = 0; a.ph_hi = N_PHASES;
    hipLaunchKernelGGL(hybrid_fwd, dim3(grid), dim3(NWAVES * 64), LDS_BYTES, stream, a);
#endif
    const hipError_t le = hipPeekAtLastError();
    if (le != hipSuccess) fprintf(stderr, "kernel_launch: launch failed: %s\n", hipGetErrorName(le));
}
```
